# Optimizing an MI355X kernel written in HIP

```python
import jax, jax.numpy as jnp
from jax import lax
import numpy as np

D_MODEL = 1024
BATCH = 32
SEQ = 256
DEPTH = 1
DEC_BATCH = 4
DEC_SEQ = 1024
PAST_LEN = 256

GRID_W = 64
MLA_HEADS = 8
QK_NOPE = 64
QK_ROPE = 32
V_HEAD = 64
Q_LORA = 256
KV_LORA = 128
MLA_WIDTH = MLA_HEADS * V_HEAD
SGU_HEADS = 8
SGU_WIDTH = D_MODEL - MLA_WIDTH
SGU_HEAD_DIM = SGU_WIDTH // SGU_HEADS
CHUNK = 128
D_FF = 4 * D_MODEL
IN_WIDTH = Q_LORA + KV_LORA + QK_ROPE + 2 * SGU_WIDTH
AXIS_PAIRS = QK_ROPE // 4
ROPE_BASE = 10000.0
EPS = 1e-6
Q_BLOCK = 128
N_MOD = 6
ATTN_SCALE = (QK_NOPE + QK_ROPE) ** -0.5

kernel_name = "hybrid_mla_sgu_prefix_dit_step"


def _rms(x, g):
    xf = x.astype(jnp.float32)
    y = xf * lax.rsqrt(jnp.mean(jnp.square(xf), axis=-1, keepdims=True) + EPS)
    return (y * g.astype(jnp.float32)).astype(x.dtype)


def _layernorm(x, g, b):
    xf = x.astype(jnp.float32)
    mu = jnp.mean(xf, axis=-1, keepdims=True)
    var = jnp.mean(jnp.square(xf - mu), axis=-1, keepdims=True)
    y = (xf - mu) * lax.rsqrt(var + EPS)
    return (y * g.astype(jnp.float32) + b.astype(jnp.float32)).astype(x.dtype)


def _axial_rope(n_tok):
    rows = n_tok // GRID_W
    row = jnp.broadcast_to(jnp.arange(rows)[:, None], (rows, GRID_W)).reshape(-1).astype(jnp.float32)
    col = jnp.broadcast_to(jnp.arange(GRID_W)[None, :], (rows, GRID_W)).reshape(-1).astype(jnp.float32)
    freqs = 1.0 / (ROPE_BASE ** (jnp.arange(AXIS_PAIRS, dtype=jnp.float32) / AXIS_PAIRS))
    ang = jnp.concatenate([row[:, None] * freqs, col[:, None] * freqs], axis=-1)
    return jnp.cos(ang), jnp.sin(ang)


def _apply_rope(x, cos, sin):
    shape = (cos.shape[0],) + (1,) * (x.ndim - 3) + (cos.shape[1],)
    c = cos.reshape(shape)
    s = sin.reshape(shape)
    xf = x.astype(jnp.float32)
    x1, x2 = xf[..., 0::2], xf[..., 1::2]
    out = jnp.stack([x1 * c - x2 * s, x1 * s + x2 * c], axis=-1).reshape(x.shape)
    return out.astype(x.dtype)


def _modulation(cond, w_mod, b_mod):
    m = jax.nn.silu(cond) @ w_mod + b_mod
    return [t[:, None, :] for t in jnp.split(m, N_MOD, axis=-1)]


def _attend(q, k, v):
    B, T, H, Dq = q.shape
    nblk = T // Q_BLOCK
    qb = q.reshape(B, nblk, Q_BLOCK, H, Dq).transpose(1, 0, 2, 3, 4)

    def one(qblk):
        s = jnp.einsum('bqhd,bkhd->bhqk', qblk, k).astype(jnp.float32) * ATTN_SCALE
        p = jax.nn.softmax(s, axis=-1).astype(v.dtype)
        return jnp.einsum('bhqk,bkhd->bqhd', p, v)

    out = lax.map(one, qb)
    return out.transpose(1, 0, 2, 3, 4).reshape(B, T, H * v.shape[-1])


def _expand_kv(ckv, kr, w_ukv):
    B, L, _ = ckv.shape
    kv = (ckv @ w_ukv).reshape(B, L, MLA_HEADS, QK_NOPE + V_HEAD)
    k_nope, val = kv[..., :QK_NOPE], kv[..., QK_NOPE:]
    k_rope = jnp.broadcast_to(kr[:, :, None, :], (B, L, MLA_HEADS, QK_ROPE))
    return jnp.concatenate([k_nope, k_rope], axis=-1), val


def _sgu(u, v, w_sgu, b_sgu, g_sgu, beta_sgu):
    B, T, _ = v.shape
    vn = _layernorm(v, g_sgu, beta_sgu).reshape(B, T // CHUNK, CHUNK, SGU_HEADS, SGU_HEAD_DIM)
    mixed = jnp.einsum('gpq,bnqgc->bnpgc', w_sgu, vn) + b_sgu.T[:, :, None]
    return u * mixed.reshape(B, T, SGU_WIDTH)


def _layer(x, mod, p, ctx_ckv=None, ctx_kr=None, rope=None):
    shift_a, scale_a, gate_a, shift_f, scale_f, gate_f = mod
    B, T, _ = x.shape
    h = _rms(x, p['g_attn_pre']) * (1.0 + scale_a) + shift_a
    proj = h @ p['w_in']
    i0 = Q_LORA
    i1 = i0 + KV_LORA
    i2 = i1 + QK_ROPE
    i3 = i2 + SGU_WIDTH
    cq, ckv, kr = proj[..., :i0], proj[..., i0:i1], proj[..., i1:i2]
    u, v = jax.nn.gelu(proj[..., i2:i3]), jax.nn.gelu(proj[..., i3:])
    q = (_rms(cq, p['g_q']) @ p['w_uq']).reshape(B, T, MLA_HEADS, QK_NOPE + QK_ROPE)
    ckv = _rms(ckv, p['g_kv'])
    if rope is None:
        k, val = _expand_kv(ckv, kr, p['w_ukv'])
    else:
        cos, sin = rope
        q = jnp.concatenate([q[..., :QK_NOPE], _apply_rope(q[..., QK_NOPE:], cos, sin)], axis=-1)
        k_lat, v_lat = _expand_kv(ckv, _apply_rope(kr, cos, sin), p['w_ukv'])
        k_ctx, v_ctx = _expand_kv(ctx_ckv, ctx_kr, p['w_ukv'])
        k = jnp.concatenate([k_ctx, k_lat], axis=1)
        val = jnp.concatenate([v_ctx, v_lat], axis=1)
    attn = _attend(q, k, val)
    sgu = _sgu(u, v, p['w_sgu'], p['b_sgu'], p['g_sgu'], p['beta_sgu'])
    mix = jnp.concatenate([attn, sgu], axis=-1) @ p['w_o']
    x = x + gate_a * _rms(mix, p['g_attn_post'])
    h = _rms(x, p['g_ffn_pre']) * (1.0 + scale_f) + shift_f
    f = jnp.square(jax.nn.relu(h @ p['w_ff1'])) @ p['w_ff2']
    x = x + gate_f * _rms(f, p['g_ffn_post'])
    return x, ckv, kr


def setup_inputs(seed: int = 0) -> dict:
    key = jax.random.key(seed)
    ks = jax.random.split(key, 24)
    n = lambda k, s, sc: jax.random.normal(k, s, jnp.float32) * sc
    L = DEPTH
    return {
        'x_prompt': n(ks[0], (BATCH, SEQ, D_MODEL), 1.0),
        'x_sample': n(ks[1], (DEC_BATCH, DEC_SEQ, D_MODEL), 1.0),
        'cache_ckv': n(ks[2], (DEC_BATCH, DEPTH, PAST_LEN, KV_LORA), 1.0),
        'cache_krope': n(ks[3], (DEC_BATCH, DEPTH, PAST_LEN, QK_ROPE), 1.0),
        'c': n(ks[4], (DEC_BATCH, D_MODEL), 1.0),
        'c_ctx': n(ks[5], (D_MODEL,), 1.0),
        'w_mod': n(ks[6], (L, D_MODEL, N_MOD * D_MODEL), 0.5 * D_MODEL ** -0.5),
        'b_mod': n(ks[7], (L, N_MOD * D_MODEL), 0.02),
        'g_attn_pre': 1.0 + n(ks[8], (L, D_MODEL), 0.05),
        'g_attn_post': 1.0 + n(ks[9], (L, D_MODEL), 0.05),
        'w_in': n(ks[10], (L, D_MODEL, IN_WIDTH), D_MODEL ** -0.5),
        'g_q': 1.0 + n(ks[11], (L, Q_LORA), 0.05),
        'w_uq': n(ks[12], (L, Q_LORA, MLA_HEADS * (QK_NOPE + QK_ROPE)), Q_LORA ** -0.5),
        'g_kv': 1.0 + n(ks[13], (L, KV_LORA), 0.05),
        'w_ukv': n(ks[14], (L, KV_LORA, MLA_HEADS * (QK_NOPE + V_HEAD)), KV_LORA ** -0.5),
        'w_sgu': n(ks[15], (L, SGU_HEADS, CHUNK, CHUNK), CHUNK ** -0.5),
        'b_sgu': 1.0 + n(ks[16], (L, SGU_HEADS, CHUNK), 0.02),
        'g_sgu': 1.0 + n(ks[17], (L, SGU_WIDTH), 0.05),
        'beta_sgu': n(ks[18], (L, SGU_WIDTH), 0.02),
        'w_o': n(ks[19], (L, D_MODEL, D_MODEL), D_MODEL ** -0.5),
        'g_ffn_pre': 1.0 + n(ks[20], (L, D_MODEL), 0.05),
        'g_ffn_post': 1.0 + n(ks[21], (L, D_MODEL), 0.05),
        'w_ff1': n(ks[22], (L, D_MODEL, D_FF), D_MODEL ** -0.5),
        'w_ff2': n(ks[23], (L, D_FF, D_MODEL), D_FF ** -0.5),
    }


def reference(x_prompt, x_sample, cache_ckv, cache_krope, c, c_ctx,
              w_mod, b_mod, g_attn_pre, g_attn_post, w_in, g_q, w_uq, g_kv, w_ukv,
              w_sgu, b_sgu, g_sgu, beta_sgu, w_o, g_ffn_pre, g_ffn_post, w_ff1, w_ff2):
    rope = _axial_rope(x_sample.shape[1])
    xp = x_prompt
    xs = x_sample
    new_ckv = []
    new_kr = []
    for l in range(DEPTH):
        p = {'g_attn_pre': g_attn_pre[l], 'g_attn_post': g_attn_post[l], 'w_in': w_in[l],
             'g_q': g_q[l], 'w_uq': w_uq[l], 'g_kv': g_kv[l], 'w_ukv': w_ukv[l],
             'w_sgu': w_sgu[l], 'b_sgu': b_sgu[l], 'g_sgu': g_sgu[l], 'beta_sgu': beta_sgu[l],
             'w_o': w_o[l], 'g_ffn_pre': g_ffn_pre[l], 'g_ffn_post': g_ffn_post[l],
             'w_ff1': w_ff1[l], 'w_ff2': w_ff2[l]}
        mod_ctx = _modulation(c_ctx[None, :], w_mod[l], b_mod[l])
        xp, ckv_l, kr_l = _layer(xp, mod_ctx, p)
        new_ckv.append(ckv_l)
        new_kr.append(kr_l)
        mod_lat = _modulation(c, w_mod[l], b_mod[l])
        xs, _, _ = _layer(xs, mod_lat, p, ctx_ckv=cache_ckv[:, l], ctx_kr=cache_krope[:, l], rope=rope)
    new_cache_ckv = jnp.stack(new_ckv, axis=1)
    new_cache_krope = jnp.stack(new_kr, axis=1)
    return (xp, xs, new_cache_ckv, new_cache_krope)
```

```cpp
#include <hip/hip_runtime.h>
#include <hip/hip_cooperative_groups.h>
#include <cstdio>
#include <cstdint>
namespace cg = cooperative_groups;
namespace pg8 {
#define PG8_LAS __attribute__((address_space(3)))
typedef unsigned short bf16_t;
typedef short bf16x8 __attribute__((ext_vector_type(8)));
typedef float f32x4 __attribute__((ext_vector_type(4)));
typedef unsigned u32x4 __attribute__((ext_vector_type(4)));
constexpr int BM = 256, BK = 64, HALF = 128, HTB = HALF * BK * 2  , STAGE_BYTES = 8 * HTB, NXCD = 8, WGM = 8;

__host__ __device__ __forceinline__ int lds_byte(int r, int c) { const int st = (r >> 4) * 2 + (c >> 5), rr = r & 15, cc = c & 31, ob = rr * 64 + cc * 2; return st * 1024 + (ob ^ (((ob >> 9) & 1) << 5)); }
__host__ __device__ __forceinline__ void stage_rc(int b, int& R, int& C) { const int st = b / 1024, sb = b % 1024, swz = sb ^ (((sb >> 9) & 1) << 5); R = (st >> 1) * 16 + swz / 64; C = (st & 1) * 32 + (swz % 64) / 2; }
__host__ __device__ __forceinline__ int perm32(int rho) { const int n = rho >> 4, i = rho & 15; return 8 * (i >> 2) + 4 * n + (i & 3); }

struct Unit { int pm, pn; };
struct Gemm { const bf16_t* A; const bf16_t* Bt; int M, N, K; };

struct StaticOrder {
    int nM, nN, nwg, G, c;
    __host__ __device__ void init(int M, int N, int G_, int c_) { nM = M / BM; nN = N / BM; nwg = nM * nN; G = G_; c = c_; }
    __host__ __device__ bool next(int i, Unit& u) const {
        const long L = (long)i * G + c; if (L >= nwg) return false;
        int wgid = (int)L; { const int q = nwg / NXCD, r = nwg % NXCD, xcd = wgid % NXCD, off = wgid / NXCD; wgid = (xcd < r ? xcd * (q + 1) : r * (q + 1) + (xcd - r) * q) + off; }
        const int nig = WGM * nN, gid = wgid / nig, fm = gid * WGM, gsz = (nM - fm) < WGM ? (nM - fm) : WGM;
        u.pm = fm + ((wgid % nig) % gsz); u.pn = (wgid % nig) / gsz; return true;
    }
    __device__ __forceinline__ void a_ready(const Unit&) const {}
    __device__ __forceinline__ void done(const Unit&) const {}
};

__device__ __forceinline__ unsigned cvt_pk_bf16(float lo, float hi) { unsigned r; asm volatile("v_cvt_pk_bf16_f32 %0, %1, %2" : "=v"(r) : "v"(lo), "v"(hi)); return r; }
typedef float f32x2 __attribute__((ext_vector_type(2)));
template <class Epi, class Sched, bool ALIGN_EPI = false, bool SP2 = false>
__device__ __forceinline__ void gemm_phase(PG8_LAS unsigned char* lds, const Gemm g, const Sched& S, const Epi& E) {
    int tid0_ = threadIdx.x; asm volatile("" : "+v"(tid0_)); const int tid = tid0_, wid = __builtin_amdgcn_readfirstlane(tid >> 6), lane = tid & 63, wr = wid >> 2, wc = wid & 3, fr = lane & 15, fq = lane >> 4;
    const int K = g.K, nt = K / BK;
    unsigned voffA[2], voffB[2];
#pragma unroll
    for (int i = 0; i < 2; ++i) { int R, C; stage_rc(tid * 16 + i * 8192, R, C); const int Rb = Epi::PERM ? ((R & ~31) + perm32(R & 31)) : R;
        voffA[i] = (unsigned)(R * K + C) * 2u; voffB[i] = (unsigned)(Rb * K + C) * 2u; }
    const size_t kstep = (size_t)(BK * 2);
    const size_t hstep = (size_t)HALF * K * 2;
    const size_t tstep = 2 * hstep;
    const unsigned ldsw = (unsigned)wid * 1024u;
    const int aoff = lds_byte(wr * 64 + fr, fq * 8), boff = lds_byte(wc * 32 + fr, fq * 8);
#define PG8_SA(b, h) (((b) * 2 + (h)) * HTB)
#define PG8_SB(b, h) ((4 + (b) * 2 + (h)) * HTB)
#define PG8_STAGE(bufoff, gbase, voff) do { _Pragma("unroll") for (int _i = 0; _i < 2; ++_i) \
        __builtin_amdgcn_global_load_lds((const unsigned*)((const char*)(gbase) + (voff)[_i]), (PG8_LAS unsigned*)(lds + (bufoff) + ldsw + _i * 8192), 16, 0, 0); } while (0)
#define PG8_LDA(dst, b, h) do { _Pragma("unroll") for (int m = 0; m < 4; ++m) _Pragma("unroll") for (int k = 0; k < 2; ++k) dst[m][k] = *(const PG8_LAS bf16x8*)(lds + PG8_SA(b, h) + aoff + m * 2048 + k * 1024); } while (0)
#define PG8_LDB(dst, b, h) do { _Pragma("unroll") for (int n = 0; n < 2; ++n) _Pragma("unroll") for (int k = 0; k < 2; ++k) dst[n][k] = *(const PG8_LAS bf16x8*)(lds + PG8_SB(b, h) + boff + n * 2048 + k * 1024); } while (0)
#define PG8_MMA(ai, bj, At, Bt) do { __builtin_amdgcn_s_setprio(1); _Pragma("unroll") for (int m = 0; m < 4; ++m) _Pragma("unroll") for (int n = 0; n < 2; ++n) _Pragma("unroll") for (int k = 0; k < 2; ++k) \
        acc[ai][bj][m][n] = __builtin_amdgcn_mfma_f32_16x16x32_bf16(Bt[n][k], At[m][k], acc[ai][bj][m][n], 0, 0, 0); __builtin_amdgcn_s_setprio(0); } while (0)
#define PG8_WAIT_V(n) asm volatile("s_waitcnt vmcnt(" #n ")" ::: "memory")
#define PG8_WAIT_L(n) asm volatile("s_waitcnt lgkmcnt(" #n ")" ::: "memory")
#define PG8_BAR __builtin_amdgcn_s_barrier()
#define PG8_SCHED __builtin_amdgcn_sched_barrier(0)
    Unit cur, nxt; int ui = 0;
    if (!S.next(0, cur)) return;
    f32x4 acc[2][2][4][2];
#pragma unroll
    for (int a = 0; a < 2; ++a)
#pragma unroll
        for (int b = 0; b < 2; ++b)
#pragma unroll
            for (int m = 0; m < 4; ++m)
#pragma unroll
                for (int n = 0; n < 2; ++n) acc[a][b][m][n] = (f32x4){0.f, 0.f, 0.f, 0.f};
    bf16x8 At[4][2], B0[2][2], B1[2][2];
    const char* cA = (const char*)g.A + (size_t)cur.pm * tstep; const char* cB = (const char*)g.Bt + (size_t)cur.pn * tstep;
    S.a_ready(cur);
    if constexpr (SP2) {
        PG8_STAGE(PG8_SB(0, 0), cB, voffB); PG8_STAGE(PG8_SB(0, 1), cB + hstep, voffB); PG8_STAGE(PG8_SA(0, 0), cA, voffA); PG8_STAGE(PG8_SA(0, 1), cA + hstep, voffA);
        if (wr == 1) PG8_BAR;
        PG8_WAIT_V(2); PG8_BAR;
        PG8_STAGE(PG8_SB(1, 0), cB + kstep, voffB); PG8_STAGE(PG8_SA(1, 0), cA + kstep, voffA); PG8_STAGE(PG8_SB(1, 1), cB + hstep + kstep, voffB);
        PG8_WAIT_V(6); PG8_BAR;
    } else {
        PG8_STAGE(PG8_SB(0, 0), cB, voffB); PG8_STAGE(PG8_SA(0, 0), cA, voffA); PG8_STAGE(PG8_SB(0, 1), cB + hstep, voffB); PG8_STAGE(PG8_SA(0, 1), cA + hstep, voffA);
        if (wr == 1) PG8_BAR;
        PG8_WAIT_V(4); PG8_BAR;
        PG8_STAGE(PG8_SB(1, 0), cB + kstep, voffB); PG8_STAGE(PG8_SA(1, 0), cA + kstep, voffA); PG8_STAGE(PG8_SB(1, 1), cB + hstep + kstep, voffB);
        PG8_WAIT_V(6); PG8_BAR;
    }
    for (;;) {
        const bool has_next = S.next(ui + 1, nxt);
        const char* nA = has_next ? (const char*)g.A + (size_t)nxt.pm * tstep : cA; const char* nB = has_next ? (const char*)g.Bt + (size_t)nxt.pn * tstep : cB;
        for (int t = 0; t < nt; t += 2) {
            const bool last = (t == nt - 2);
            const char* a1 = cA + (size_t)(t + 1) * kstep;
            const char* a2 = last ? nA : cA + (size_t)(t + 2) * kstep; const char* b2 = last ? nB : cB + (size_t)(t + 2) * kstep;
            const char* a3 = a2 + kstep; const char* b3 = b2 + kstep;
            if (last && has_next) S.a_ready(nxt);
            if constexpr (SP2) {
            PG8_LDB(B0, 0, 0); PG8_LDB(B1, 0, 1); PG8_SCHED; PG8_LDA(At, 0, 0); PG8_STAGE(PG8_SA(1, 1), a1 + hstep, voffA);
            PG8_WAIT_V(8); PG8_WAIT_L(0); PG8_BAR; PG8_MMA(0, 0, At, B0); PG8_MMA(0, 1, At, B1); PG8_BAR; PG8_SCHED;
            PG8_LDA(At, 0, 1); PG8_STAGE(PG8_SB(0, 0), b2, voffB); PG8_STAGE(PG8_SB(0, 1), b2 + hstep, voffB); PG8_STAGE(PG8_SA(0, 0), a2, voffA);
            PG8_WAIT_V(8); PG8_WAIT_L(0); PG8_BAR; PG8_MMA(1, 0, At, B0); PG8_MMA(1, 1, At, B1); PG8_BAR; PG8_SCHED;
            PG8_LDB(B0, 1, 0); PG8_LDB(B1, 1, 1); PG8_SCHED; PG8_LDA(At, 1, 0); PG8_STAGE(PG8_SA(0, 1), a2 + hstep, voffA);
            PG8_WAIT_V(8); PG8_WAIT_L(0); PG8_BAR; PG8_MMA(0, 0, At, B0); PG8_MMA(0, 1, At, B1); PG8_BAR; PG8_SCHED;
            PG8_LDA(At, 1, 1); PG8_STAGE(PG8_SB(1, 0), b3, voffB); PG8_STAGE(PG8_SB(1, 1), b3 + hstep, voffB); PG8_STAGE(PG8_SA(1, 0), a3, voffA);
            PG8_WAIT_V(8); PG8_WAIT_L(0); PG8_BAR; PG8_MMA(1, 0, At, B0); PG8_MMA(1, 1, At, B1); PG8_BAR; PG8_SCHED;
            } else {
            PG8_LDB(B0, 0, 0); PG8_SCHED; PG8_LDA(At, 0, 0); PG8_STAGE(PG8_SA(1, 1), a1 + hstep, voffA);
            PG8_WAIT_L(8); PG8_BAR; PG8_WAIT_L(0); PG8_MMA(0, 0, At, B0); PG8_BAR; PG8_SCHED;
            PG8_LDB(B1, 0, 1); PG8_STAGE(PG8_SB(0, 0), b2, voffB);
            PG8_BAR; PG8_WAIT_L(0); PG8_MMA(0, 1, At, B1); PG8_BAR;
            PG8_LDA(At, 0, 1); PG8_STAGE(PG8_SA(0, 0), a2, voffA);
            PG8_BAR; PG8_WAIT_L(0); PG8_MMA(1, 0, At, B0); PG8_BAR; PG8_SCHED;
            PG8_STAGE(PG8_SB(0, 1), b2 + hstep, voffB);
            PG8_WAIT_V(6); PG8_BAR; PG8_MMA(1, 1, At, B1); PG8_BAR;
            PG8_LDB(B0, 1, 0); PG8_SCHED; PG8_LDA(At, 1, 0); PG8_STAGE(PG8_SA(0, 1), a2 + hstep, voffA);
            PG8_WAIT_L(8); PG8_BAR; PG8_WAIT_L(0); PG8_MMA(0, 0, At, B0); PG8_BAR; PG8_SCHED;
            PG8_LDB(B1, 1, 1); PG8_STAGE(PG8_SB(1, 0), b3, voffB);
            PG8_BAR; PG8_WAIT_L(0); PG8_MMA(0, 1, At, B1); PG8_BAR;
            PG8_LDA(At, 1, 1); PG8_STAGE(PG8_SA(1, 0), a3, voffA);
            PG8_BAR; PG8_WAIT_L(0); PG8_MMA(1, 0, At, B0); PG8_BAR; PG8_SCHED;
            PG8_STAGE(PG8_SB(1, 1), b3 + hstep, voffB);
            PG8_WAIT_V(6); PG8_BAR; PG8_MMA(1, 1, At, B1); PG8_BAR;
            }
        }
        if constexpr (ALIGN_EPI) { if (wr == 0) PG8_BAR; }
        if constexpr (!Epi::AFTER_DRAIN) { E(acc, cur, wr, wc, fr, fq); S.done(cur); }
        if (!has_next) break;
#pragma unroll
        for (int a = 0; a < 2; ++a)
#pragma unroll
            for (int b = 0; b < 2; ++b)
#pragma unroll
                for (int m = 0; m < 4; ++m)
#pragma unroll
                    for (int n = 0; n < 2; ++n) acc[a][b][m][n] = (f32x4){0.f, 0.f, 0.f, 0.f};
        cur = nxt; cA = nA; cB = nB; ++ui;
        if constexpr (ALIGN_EPI) { if (wr == 1) PG8_BAR; }
    }
    PG8_WAIT_V(0);
    if constexpr (!ALIGN_EPI) { if (wr == 0) PG8_BAR; }
    PG8_BAR;
    if constexpr (Epi::AFTER_DRAIN) { E.fused(acc, cur, wr, wc, fr, fq, lds, wid, lane); S.done(cur); }
#undef PG8_SA
#undef PG8_SB
#undef PG8_STAGE
#undef PG8_LDA
#undef PG8_LDB
#undef PG8_MMA
#undef PG8_WAIT_V
#undef PG8_WAIT_L
#undef PG8_BAR
#undef PG8_SCHED
}
}
#define LAS __attribute__((address_space(3)))
typedef unsigned short bf16_t;
typedef short bf16x8 __attribute__((ext_vector_type(8)));
typedef float f32x4 __attribute__((ext_vector_type(4)));
typedef float f32x2 __attribute__((ext_vector_type(2)));
typedef unsigned u32x4 __attribute__((ext_vector_type(4)));
typedef unsigned u32x2 __attribute__((ext_vector_type(2)));
using pg8::cvt_pk_bf16;

constexpr int D = 1024, NCTX = 8192, NLAT = 4096, MTOK = 12288, NKV = 13312;
constexpr int NPROJ = 1536;
constexpr int DFF = 4096;
constexpr float EPS = 1e-6f;
constexpr float QSCALE = 0.10206207261596575f * 1.4426950408889634f;

constexpr size_t MiB = 1u << 20;
constexpr size_t WS_MOD = 0;
constexpr size_t WS_ROPE = 128 * 1024;
constexpr size_t WS_VSTAT = 256 * 1024;
constexpr size_t WS_WUQ = 512 * 1024;
constexpr size_t WS_WK = 896 * 1024;
constexpr size_t WS_WV = 1024 * 1024;
constexpr size_t WS_WSGU = 1152 * 1024;
constexpr size_t WS_WIN = 2 * MiB;
constexpr size_t WS_WO = 5 * MiB;
constexpr size_t WS_W1 = 7 * MiB;
constexpr size_t WS_W2 = 15 * MiB;
constexpr size_t WS_H = 24 * MiB;
constexpr size_t WS_UV = 48 * MiB;
constexpr size_t WS_F = WS_UV;
constexpr size_t WS_PROJ = 72 * MiB;
constexpr size_t WS_MIXO = WS_PROJ;
constexpr size_t WS_CQN = 96 * MiB;
constexpr size_t WS_CKVN = 102 * MiB;
constexpr size_t WS_KR = 106 * MiB;
constexpr size_t WS_Q = 107 * MiB;
constexpr size_t WS_KN = 125 * MiB;
constexpr size_t WS_VT = 138 * MiB;
constexpr size_t WS_MIX = 151 * MiB;
constexpr size_t WS_A1 = 72 * MiB;
constexpr size_t WS_END = 176 * MiB;

constexpr size_t OUT_Y = 0, OUT_CKV = (size_t)MTOK * D, OUT_KR = OUT_CKV + (size_t)NCTX * 128;

struct Params {
    const float *x_prompt, *x_sample, *cache_ckv, *cache_krope, *c, *c_ctx, *w_mod, *b_mod, *g_attn_pre, *g_attn_post, *w_in, *g_q, *w_uq, *g_kv, *w_ukv,
        *w_sgu, *b_sgu, *g_sgu, *beta_sgu, *w_o, *g_ffn_pre, *g_ffn_post, *w_ff1, *w_ff2;
    float* out; unsigned char* ws;
};

__device__ __forceinline__ float bf2f(unsigned short b) { return __uint_as_float((unsigned)b << 16); }
__device__ __forceinline__ float bflo(unsigned w) { return __uint_as_float(w << 16); }
__device__ __forceinline__ float bfhi(unsigned w) { return __uint_as_float(w & 0xffff0000u); }
__device__ __forceinline__ float wave_sum(float v) {
#pragma unroll
    for (int o = 1; o < 64; o <<= 1) v += __shfl_xor(v, o);
    return v;
}
__device__ __forceinline__ const float* xrow(const Params& p, int r) { return r < NCTX ? p.x_prompt + (size_t)r * D : p.x_sample + (size_t)(r - NCTX) * D; }
__device__ __forceinline__ int cls_of(int r) { return r < NCTX ? 0 : 1 + ((r - NCTX) >> 10); }
__device__ __forceinline__ int kvrow_of(int r) { return r < NCTX ? r : NCTX + ((r - NCTX) >> 10) * 1280 + 256 + ((r - NCTX) & 1023); }
__device__ __forceinline__ float gelu_tanh(float x) {
    const float u = 0.7978845608028654f * (x + 0.044715f * x * x * x);
    return x / (1.0f + __builtin_amdgcn_exp2f(-2.0f * 1.4426950408889634f * u));
}

template <int ACT  > struct EpiStore {
    static constexpr bool PERM = true, AFTER_DRAIN = false;
    bf16_t* O; int ldc;
    __device__ __forceinline__ void operator()(const f32x4 (&acc)[2][2][4][2], const pg8::Unit& u, int wr, int wc, int fr, int fq) const {
        const int row0 = u.pm * 256 + wr * 64 + fr, col0 = u.pn * 256 + wc * 32 + 8 * fq;
#pragma unroll
        for (int ai = 0; ai < 2; ++ai)
#pragma unroll
            for (int m = 0; m < 4; ++m) { bf16_t* rowp = O + (size_t)(row0 + ai * 128 + m * 16) * ldc + col0;
#pragma unroll
                for (int bj = 0; bj < 2; ++bj) { f32x4 v0 = acc[ai][bj][m][0], v1 = acc[ai][bj][m][1];
                    if (ACT == 1) {
#pragma unroll
                        for (int e = 0; e < 4; ++e) { float a = fmaxf(v0[e], 0.f), b = fmaxf(v1[e], 0.f); v0[e] = a * a; v1[e] = b * b; } }
                    u32x4 w; w.x = cvt_pk_bf16(v0[0], v0[1]); w.y = cvt_pk_bf16(v0[2], v0[3]); w.z = cvt_pk_bf16(v1[0], v1[1]); w.w = cvt_pk_bf16(v1[2], v1[3]);
                    *(u32x4*)(rowp + bj * 128) = w; } }
    }
};
struct EpiInProj {
    static constexpr bool PERM = true, AFTER_DRAIN = false;
    float* PROJ; bf16_t* UV;
    __device__ __forceinline__ void operator()(const f32x4 (&acc)[2][2][4][2], const pg8::Unit& u, int wr, int wc, int fr, int fq) const {
        const int row0 = u.pm * 256 + wr * 64 + fr, colt = wc * 32 + 8 * fq;
        if (u.pn < 2) {
#pragma unroll
            for (int ai = 0; ai < 2; ++ai)
#pragma unroll
                for (int m = 0; m < 4; ++m) { float* rowp = PROJ + (size_t)(row0 + ai * 128 + m * 16) * 512 + u.pn * 256 + colt;
#pragma unroll
                    for (int bj = 0; bj < 2; ++bj) { *(f32x4*)(rowp + bj * 128) = acc[ai][bj][m][0]; *(f32x4*)(rowp + bj * 128 + 4) = acc[ai][bj][m][1]; } }
        } else {
#pragma unroll
            for (int ai = 0; ai < 2; ++ai)
#pragma unroll
                for (int m = 0; m < 4; ++m) { bf16_t* rowp = UV + (size_t)(row0 + ai * 128 + m * 16) * 1024 + (u.pn - 2) * 256 + colt;
#pragma unroll
                    for (int bj = 0; bj < 2; ++bj) { f32x4 v0 = acc[ai][bj][m][0], v1 = acc[ai][bj][m][1];
#pragma unroll
                        for (int e = 0; e < 4; ++e) { v0[e] = gelu_tanh(v0[e]); v1[e] = gelu_tanh(v1[e]); }
                        u32x4 w; w.x = cvt_pk_bf16(v0[0], v0[1]); w.y = cvt_pk_bf16(v0[2], v0[3]); w.z = cvt_pk_bf16(v1[0], v1[1]); w.w = cvt_pk_bf16(v1[2], v1[3]);
                        *(u32x4*)(rowp + bj * 128) = w; } }
        }
    }
};
struct EpiQ {
    static constexpr bool PERM = true, AFTER_DRAIN = false;
    bf16_t* Q; const float* rope;
    __device__ __forceinline__ void operator()(const f32x4 (&acc)[2][2][4][2], const pg8::Unit& u, int wr, int wc, int fr, int fq) const {
        const int row0 = u.pm * 256 + wr * 64 + fr, col0 = u.pn * 256 + wc * 32 + 8 * fq;
        const bool lat = (u.pm * 256) >= NCTX;
#pragma unroll
        for (int ai = 0; ai < 2; ++ai)
#pragma unroll
            for (int m = 0; m < 4; ++m) { const int row = row0 + ai * 128 + m * 16; bf16_t* rowp = Q + (size_t)row * 768 + col0;
#pragma unroll
                for (int bj = 0; bj < 2; ++bj) { f32x4 v0 = acc[ai][bj][m][0], v1 = acc[ai][bj][m][1];
                    const int hc = (col0 + bj * 128) % 96;
                    if (lat && hc >= 64) { const int t = (row - NCTX) & 1023; const f32x4* rp = (const f32x4*)(rope + (size_t)t * 32 + (hc - 64));
                        const f32x4 r0 = rp[0], r1 = rp[1];
                        f32x4 o0, o1;
                        o0[0] = v0[0] * r0[0] - v0[1] * r0[1]; o0[1] = v0[0] * r0[1] + v0[1] * r0[0];
                        o0[2] = v0[2] * r0[2] - v0[3] * r0[3]; o0[3] = v0[2] * r0[3] + v0[3] * r0[2];
                        o1[0] = v1[0] * r1[0] - v1[1] * r1[1]; o1[1] = v1[0] * r1[1] + v1[1] * r1[0];
                        o1[2] = v1[2] * r1[2] - v1[3] * r1[3]; o1[3] = v1[2] * r1[3] + v1[3] * r1[2];
                        v0 = o0; v1 = o1; }
                    v0 = v0 * QSCALE; v1 = v1 * QSCALE;
                    u32x4 w; w.x = cvt_pk_bf16(v0[0], v0[1]); w.y = cvt_pk_bf16(v0[2], v0[3]); w.z = cvt_pk_bf16(v1[0], v1[1]); w.w = cvt_pk_bf16(v1[2], v1[3]);
                    *(u32x4*)(rowp + bj * 128) = w; } }
    }
};

__device__ __forceinline__ unsigned pk2(float lo, float hi) { return cvt_pk_bf16(lo, hi); }
__device__ __forceinline__ void transpose_item(const float* W, int K, int N, bf16_t* WT, int k0, int n0, int dst_row0, LAS float* scr, int lane) {
#pragma unroll 8
    for (int i = 0; i < 32; ++i) { const int kk = 2 * i + (lane >> 5); scr[kk * 33 + (lane & 31)] = W[(size_t)(k0 + kk) * N + n0 + (lane & 31)]; }
    asm volatile("s_waitcnt lgkmcnt(0)" ::: "memory");
    const int c = lane & 7;
#pragma unroll
    for (int j = 0; j < 4; ++j) { const int n = (lane >> 3) + 8 * j; const LAS float* s = scr + (8 * c) * 33 + n;
        u32x4 o; o.x = pk2(s[0 * 33], s[1 * 33]); o.y = pk2(s[2 * 33], s[3 * 33]); o.z = pk2(s[4 * 33], s[5 * 33]); o.w = pk2(s[6 * 33], s[7 * 33]);
        *(u32x4*)(WT + (size_t)(dst_row0 + n) * K + k0 + 8 * c) = o; }
    asm volatile("s_waitcnt lgkmcnt(0)" ::: "memory");
}
__device__ __forceinline__ void phase0(const Params& p, LAS unsigned char* lds) {
    int tid0_ = threadIdx.x; asm volatile("" : "+v"(tid0_)); const int tid = tid0_, lane = tid & 63, wave = tid >> 6, G = gridDim.x;
    unsigned char* ws = p.ws;
    float* MOD = (float*)(ws + WS_MOD);
    for (int s = blockIdx.x; s < 192; s += G) {
        LAS float* sl = (LAS float*)lds; LAS float* red = sl + 5 * 1024;
        for (int e = tid; e < 5 * 1024; e += 512) { const int i = e >> 10, k = e & 1023; const float v = (i == 0) ? p.c_ctx[k] : p.c[(i - 1) * 1024 + k]; sl[e] = v / (1.0f + expf(-v)); }
        __syncthreads();
        const int col = tid & 31, kg = tid >> 5;
        float a0 = 0.f, a1 = 0.f, a2 = 0.f, a3 = 0.f, a4 = 0.f;
        const float* w = p.w_mod + (size_t)(kg * 64) * 6144 + s * 32 + col;
#pragma unroll 8
        for (int kk = 0; kk < 64; ++kk) { const float wv = w[(size_t)kk * 6144]; const int k = kg * 64 + kk;
            a0 += sl[k] * wv; a1 += sl[1024 + k] * wv; a2 += sl[2048 + k] * wv; a3 += sl[3072 + k] * wv; a4 += sl[4096 + k] * wv; }
        red[(kg * 5 + 0) * 32 + col] = a0; red[(kg * 5 + 1) * 32 + col] = a1; red[(kg * 5 + 2) * 32 + col] = a2; red[(kg * 5 + 3) * 32 + col] = a3; red[(kg * 5 + 4) * 32 + col] = a4;
        __syncthreads();
        if (tid < 160) { const int i = tid >> 5, cc = tid & 31; float sum = p.b_mod[s * 32 + cc];
#pragma unroll
            for (int g = 0; g < 16; ++g) sum += red[(g * 5 + i) * 32 + cc];
            MOD[i * 6144 + s * 32 + cc] = sum; }
        __syncthreads();
    }
    {
        LAS float* scr = (LAS float*)(lds + wave * 16384);
        const int gw = blockIdx.x * 8 + wave, NGW = G * 8;
        constexpr int I_IN = 16 * 45, I_UQ = 4 * 24, I_UKV = 2 * 32, I_O = 16 * 32, I_1 = 16 * 128, I_2 = 64 * 32;
        constexpr int NIT = I_IN + I_UQ + I_UKV + I_O + I_1 + I_2;
        for (int it = gw; it < NIT; it += NGW) {
            int r = it;
            if (r < I_IN) { const int kb = r / 45, nb = r % 45, n0 = nb * 32; transpose_item(p.w_in, 1024, 1440, (bf16_t*)(ws + WS_WIN), kb * 64, n0, n0 < 416 ? n0 : n0 + 96, scr, lane); continue; } r -= I_IN;
            if (r < I_UQ) { const int kb = r / 24, nb = r % 24; transpose_item(p.w_uq, 256, 768, (bf16_t*)(ws + WS_WUQ), kb * 64, nb * 32, nb * 32, scr, lane); continue; } r -= I_UQ;
            if (r < I_UKV) { const int kb = r / 32, nb = r % 32, n0 = nb * 32, h = n0 >> 7, wi = n0 & 127;
                if (wi < 64) transpose_item(p.w_ukv, 128, 1024, (bf16_t*)(ws + WS_WK), kb * 64, n0, h * 64 + wi, scr, lane);
                else transpose_item(p.w_ukv, 128, 1024, (bf16_t*)(ws + WS_WV), kb * 64, n0, h * 64 + wi - 64, scr, lane);
                continue; } r -= I_UKV;
            if (r < I_O) { const int kb = r / 32, nb = r % 32; transpose_item(p.w_o, 1024, 1024, (bf16_t*)(ws + WS_WO), kb * 64, nb * 32, nb * 32, scr, lane); continue; } r -= I_O;
            if (r < I_1) { const int kb = r / 128, nb = r % 128; transpose_item(p.w_ff1, 1024, 4096, (bf16_t*)(ws + WS_W1), kb * 64, nb * 32, nb * 32, scr, lane); continue; } r -= I_1;
            { const int kb = r / 32, nb = r % 32; transpose_item(p.w_ff2, 4096, 1024, (bf16_t*)(ws + WS_W2), kb * 64, nb * 32, nb * 32, scr, lane); }
        }
    }
    {
        const int gt = blockIdx.x * 512 + tid, NGT = G * 512;
        bf16_t* wsgu = (bf16_t*)(ws + WS_WSGU);
        for (int e = gt; e < 8 * 128 * 128 / 2; e += NGT) ((unsigned*)wsgu)[e] = pk2(p.w_sgu[2 * e], p.w_sgu[2 * e + 1]);
        unsigned* pad = (unsigned*)((bf16_t*)(ws + WS_WIN) + (size_t)416 * 1024);
        for (int e = gt; e < 96 * 1024 / 2; e += NGT) pad[e] = 0u;
        float* rope = (float*)(ws + WS_ROPE);
        for (int e = gt; e < 1024 * 16; e += NGT) { const int t = e >> 4, i = e & 15, j = i & 7; const float pos = (float)((i < 8) ? (t >> 6) : (t & 63));
            const float freq = 1.0f / powf(10000.0f, (float)j * 0.125f); const float ang = pos * freq; float sn, cs; sincosf(ang, &sn, &cs); rope[2 * e] = cs; rope[2 * e + 1] = sn; }
    }
}

__device__ __forceinline__ void phase_xn(const Params& p) {
    int tid0_ = threadIdx.x; asm volatile("" : "+v"(tid0_)); const int tid = tid0_, lane = tid & 63, wave = tid >> 6;
    const int gw = blockIdx.x * 8 + wave, NGW = gridDim.x * 8;
    const float* MOD = (const float*)(p.ws + WS_MOD); bf16_t* H = (bf16_t*)(p.ws + WS_H);
    for (int r = gw; r < MTOK; r += NGW) {
        const f32x4* xr = (const f32x4*)xrow(p, r) + lane; const float* md = MOD + cls_of(r) * 6144;
        f32x4 v[4]; float s = 0.f;
#pragma unroll
        for (int j = 0; j < 4; ++j) { v[j] = xr[64 * j]; s += (v[j][0] * v[j][0] + v[j][1] * v[j][1]) + (v[j][2] * v[j][2] + v[j][3] * v[j][3]); }
        const float rstd = 1.0f / sqrtf(wave_sum(s) * (1.0f / D) + EPS);
#pragma unroll
        for (int j = 0; j < 4; ++j) { const int col = 4 * lane + 256 * j;
            const f32x4 g = *(const f32x4*)(p.g_attn_pre + col), sh = *(const f32x4*)(md + col), sc = *(const f32x4*)(md + 1024 + col);
            const f32x4 o = v[j] * rstd * g * (sc + 1.0f) + sh;
            u32x2 w; w.x = pk2(o[0], o[1]); w.y = pk2(o[2], o[3]); *(u32x2*)(H + (size_t)r * D + col) = w; }
    }
}

__device__ __forceinline__ void phase_prep(const Params& p) {
    int tid0_ = threadIdx.x; asm volatile("" : "+v"(tid0_)); const int tid = tid0_, lane = tid & 63, wave = tid >> 6;
    const int gw = blockIdx.x * 8 + wave, NGW = gridDim.x * 8;
    unsigned char* ws = p.ws;
    const float* PROJ = (const float*)(ws + WS_PROJ); const bf16_t* UV = (const bf16_t*)(ws + WS_UV);
    bf16_t* CQN = (bf16_t*)(ws + WS_CQN); bf16_t* CKVN = (bf16_t*)(ws + WS_CKVN); bf16_t* KR = (bf16_t*)(ws + WS_KR);
    float* VSTAT = (float*)(ws + WS_VSTAT); const float* rope = (const float*)(ws + WS_ROPE);
    for (int r = gw; r < MTOK + 1024; r += NGW) {
        if (r >= MTOK) {
            const int j = r - MTOK, b = j >> 8, pp = j & 255; const size_t kvr = (size_t)NCTX + b * 1280 + pp;
            const f32x2 cv = *(const f32x2*)(p.cache_ckv + (size_t)j * 128 + 2 * lane);
            *(unsigned*)(CKVN + kvr * 128 + 2 * lane) = pk2(cv[0], cv[1]);
            if (lane < 16) { const f32x2 kv = *(const f32x2*)(p.cache_krope + (size_t)j * 32 + 2 * lane); *(unsigned*)(KR + kvr * 32 + 2 * lane) = pk2(kv[0], kv[1]); }
            continue;
        }
        const float* pr = PROJ + (size_t)r * 512; const size_t kvr = (size_t)kvrow_of(r);
        { const f32x4 v = *(const f32x4*)(pr + 4 * lane); const float s = wave_sum((v[0] * v[0] + v[1] * v[1]) + (v[2] * v[2] + v[3] * v[3]));
          const float rstd = 1.0f / sqrtf(s * (1.0f / 256.0f) + EPS); const f32x4 g = *(const f32x4*)(p.g_q + 4 * lane); const f32x4 o = v * rstd * g;
          u32x2 w; w.x = pk2(o[0], o[1]); w.y = pk2(o[2], o[3]); *(u32x2*)(CQN + (size_t)r * 256 + 4 * lane) = w; }
        { const f32x2 v = *(const f32x2*)(pr + 256 + 2 * lane); const float s = wave_sum(v[0] * v[0] + v[1] * v[1]);
          const float rstd = 1.0f / sqrtf(s * (1.0f / 128.0f) + EPS); const f32x2 g = *(const f32x2*)(p.g_kv + 2 * lane); const f32x2 o = v * rstd * g;
          if (r < NCTX) *(f32x2*)(p.out + OUT_CKV + (size_t)r * 128 + 2 * lane) = o;
          *(unsigned*)(CKVN + kvr * 128 + 2 * lane) = pk2(o[0], o[1]); }
        if (lane < 16) { f32x2 v = *(const f32x2*)(pr + 384 + 2 * lane);
          if (r < NCTX) *(f32x2*)(p.out + OUT_KR + (size_t)r * 32 + 2 * lane) = v;
          else { const int t = (r - NCTX) & 1023; const f32x2 cs = *(const f32x2*)(rope + (size_t)t * 32 + 2 * lane); v = (f32x2){v[0] * cs[0] - v[1] * cs[1], v[0] * cs[1] + v[1] * cs[0]}; }
          *(unsigned*)(KR + kvr * 32 + 2 * lane) = pk2(v[0], v[1]); }
        { const u32x4 w = *(const u32x4*)(UV + (size_t)r * 1024 + 512 + 8 * lane);
          float x[8] = {bflo(w.x), bfhi(w.x), bflo(w.y), bfhi(w.y), bflo(w.z), bfhi(w.z), bflo(w.w), bfhi(w.w)};
          float s = 0.f;
#pragma unroll
          for (int e = 0; e < 8; ++e) s += x[e];
          const float mean = wave_sum(s) * (1.0f / 512.0f); float q = 0.f;
#pragma unroll
          for (int e = 0; e < 8; ++e) { const float d = x[e] - mean; q += d * d; }
          const float rstd = 1.0f / sqrtf(wave_sum(q) * (1.0f / 512.0f) + EPS);
          if (lane == 0) *(f32x2*)(VSTAT + 2 * (size_t)r) = (f32x2){mean, rstd}; }
    }
}

__device__ __forceinline__ void sgu_unit(const Params& p, LAS unsigned char* lds, int chunk, int g) {
    int tid0_ = threadIdx.x; asm volatile("" : "+v"(tid0_)); const int tid = tid0_, lane = tid & 63, wave = tid >> 6, fr = lane & 15, g4 = lane >> 4;
    unsigned char* ws = p.ws;
    const bf16_t* UV = (const bf16_t*)(ws + WS_UV); const float* VSTAT = (const float*)(ws + WS_VSTAT); const bf16_t* WS = (const bf16_t*)(ws + WS_WSGU);
    bf16_t* MIX = (bf16_t*)(ws + WS_MIX);
    const int r0 = chunk * 128;
    LAS bf16_t* vnT = (LAS bf16_t*)lds;
    { const int row = tid >> 2, cc = (tid & 3) * 16;
      const bf16_t* src = UV + (size_t)(r0 + row) * 1024 + 512 + g * 64 + cc;
      const u32x4 w0 = *(const u32x4*)src, w1 = *(const u32x4*)(src + 8);
      const f32x2 st = *(const f32x2*)(VSTAT + 2 * (size_t)(r0 + row));
      const float x[16] = {bflo(w0.x), bfhi(w0.x), bflo(w0.y), bfhi(w0.y), bflo(w0.z), bfhi(w0.z), bflo(w0.w), bfhi(w0.w), bflo(w1.x), bfhi(w1.x), bflo(w1.y), bfhi(w1.y), bflo(w1.z), bfhi(w1.z), bflo(w1.w), bfhi(w1.w)};
#pragma unroll
      for (int e = 0; e < 16; e += 2) { const int c = cc + e;
          const f32x2 gg = *(const f32x2*)(p.g_sgu + g * 64 + c), bb = *(const f32x2*)(p.beta_sgu + g * 64 + c);
          const unsigned w = pk2((x[e] - st[0]) * st[1] * gg[0] + bb[0], (x[e + 1] - st[0]) * st[1] * gg[1] + bb[1]);
          vnT[c * 136 + row] = (bf16_t)(w & 0xffffu); vnT[(c + 1) * 136 + row] = (bf16_t)(w >> 16); } }
    __syncthreads();
    bf16x8 bfr[4];
    { const bf16_t* wp = WS + (size_t)g * 16384 + (size_t)(16 * wave + fr) * 128 + 8 * g4;
#pragma unroll
      for (int ks = 0; ks < 4; ++ks) bfr[ks] = *(const bf16x8*)(wp + 32 * ks); }
    const int token = r0 + 16 * wave + fr; const float bias = p.b_sgu[g * 128 + 16 * wave + fr];
#pragma unroll
    for (int j = 0; j < 4; ++j) { f32x4 acc = {0.f, 0.f, 0.f, 0.f};
#pragma unroll
        for (int ks = 0; ks < 4; ++ks) { const bf16x8 a = *(const LAS bf16x8*)(vnT + (16 * j + fr) * 136 + 32 * ks + 8 * g4); acc = __builtin_amdgcn_mfma_f32_16x16x32_bf16(a, bfr[ks], acc, 0, 0, 0); }
        const int c = 16 * j + 4 * g4; const u32x2 uw = *(const u32x2*)(UV + (size_t)token * 1024 + g * 64 + c);
        u32x2 o; o.x = pk2((acc[0] + bias) * bflo(uw.x), (acc[1] + bias) * bfhi(uw.x)); o.y = pk2((acc[2] + bias) * bflo(uw.y), (acc[3] + bias) * bfhi(uw.y));
        *(u32x2*)(MIX + (size_t)token * 1024 + 512 + g * 64 + c) = o; }
    __syncthreads();
}

__device__ __forceinline__ void attn_unit(const Params& p, LAS unsigned char* lds, int q0, int kv0, int NK, int h) {
    int tid0_ = threadIdx.x; asm volatile("" : "+v"(tid0_)); const int tid = tid0_, lane = tid & 63, wave = tid >> 6, fr = lane & 15, g4 = lane >> 4;
    unsigned char* ws = p.ws;
    const bf16_t* Q = (const bf16_t*)(ws + WS_Q); const bf16_t* KN = (const bf16_t*)(ws + WS_KN); const bf16_t* KR = (const bf16_t*)(ws + WS_KR); const bf16_t* VT = (const bf16_t*)(ws + WS_VT);
    bf16_t* MIX = (bf16_t*)(ws + WS_MIX);
    constexpr int KS = 208, VS = 144, VOFF = 64 * KS, BUFB = 64 * KS + 64 * VS;
    bf16x8 qf[3];
    { const bf16_t* qp = Q + (size_t)(q0 + wave * 16 + fr) * 768 + h * 96 + g4 * 8;
#pragma unroll
      for (int kd = 0; kd < 3; ++kd) qf[kd] = *(const bf16x8*)(qp + kd * 32); }
    f32x4 o[4];
#pragma unroll
    for (int dj = 0; dj < 4; ++dj) o[dj] = (f32x4){0.f, 0.f, 0.f, 0.f};
    float m = -1e30f, l = 0.f;
    const int NT = NK / 64;
    const int krow = tid >> 3, kch = tid & 7, rrow = tid >> 2, rch = tid & 3;
    const bf16_t* kn_src = KN + (size_t)(kv0 + krow) * 512 + h * 64 + kch * 8;
    const bf16_t* kr_src = KR + (size_t)(kv0 + (rrow & 63)) * 32 + rch * 8;
    const bf16_t* vt_src = VT + (size_t)(h * 64 + krow) * NKV + kv0 + kch * 8;
    u32x4 rk, rr, rv;
    rk = *(const u32x4*)kn_src; rv = *(const u32x4*)vt_src; if (tid < 256) rr = *(const u32x4*)kr_src;
    *(LAS u32x4*)(lds + krow * KS + kch * 16) = rk; *(LAS u32x4*)(lds + VOFF + krow * VS + kch * 16) = rv; if (tid < 256) *(LAS u32x4*)(lds + rrow * KS + 128 + rch * 16) = rr;
    __syncthreads();
    for (int t = 0; t < NT; ++t) {
        LAS unsigned char* buf = lds + (t & 1) * BUFB;
        if (t + 1 < NT) { rk = *(const u32x4*)(kn_src + (size_t)(t + 1) * 64 * 512); rv = *(const u32x4*)(vt_src + (t + 1) * 64); if (tid < 256) rr = *(const u32x4*)(kr_src + (size_t)(t + 1) * 64 * 32); }
        f32x4 s[4];
#pragma unroll
        for (int a = 0; a < 4; ++a) { s[a] = (f32x4){0.f, 0.f, 0.f, 0.f};
#pragma unroll
            for (int kd = 0; kd < 3; ++kd) { const bf16x8 kf = *(const LAS bf16x8*)(buf + (16 * a + fr) * KS + kd * 64 + g4 * 16); s[a] = __builtin_amdgcn_mfma_f32_16x16x32_bf16(kf, qf[kd], s[a], 0, 0, 0); } }
        float mx = fmaxf(fmaxf(s[0][0], s[0][1]), fmaxf(s[0][2], s[0][3]));
#pragma unroll
        for (int a = 1; a < 4; ++a) mx = fmaxf(mx, fmaxf(fmaxf(s[a][0], s[a][1]), fmaxf(s[a][2], s[a][3])));
        mx = fmaxf(mx, __shfl_xor(mx, 16)); mx = fmaxf(mx, __shfl_xor(mx, 32));
        const float mn = fmaxf(m, mx); const float alpha = __builtin_amdgcn_exp2f(m - mn); m = mn;
        l *= alpha;
#pragma unroll
        for (int dj = 0; dj < 4; ++dj) o[dj] = o[dj] * alpha;
        float ps = 0.f;
#pragma unroll
        for (int a = 0; a < 4; ++a)
#pragma unroll
            for (int e = 0; e < 4; ++e) { s[a][e] = __builtin_amdgcn_exp2f(s[a][e] - mn); ps += s[a][e]; }
        l += ps;
#pragma unroll
        for (int ks = 0; ks < 2; ++ks) {
            u32x4 pw; pw.x = pk2(s[2 * ks][0], s[2 * ks][1]); pw.y = pk2(s[2 * ks][2], s[2 * ks][3]); pw.z = pk2(s[2 * ks + 1][0], s[2 * ks + 1][1]); pw.w = pk2(s[2 * ks + 1][2], s[2 * ks + 1][3]);
            const bf16x8 pf = __builtin_bit_cast(bf16x8, pw);
#pragma unroll
            for (int dj = 0; dj < 4; ++dj) { const LAS unsigned char* vp = buf + VOFF + (16 * dj + fr) * VS + (32 * ks + 4 * g4) * 2;
                const u32x2 lo = *(const LAS u32x2*)vp, hi = *(const LAS u32x2*)(vp + 32);
                u32x4 vw; vw.x = lo.x; vw.y = lo.y; vw.z = hi.x; vw.w = hi.y;
                o[dj] = __builtin_amdgcn_mfma_f32_16x16x32_bf16(__builtin_bit_cast(bf16x8, vw), pf, o[dj], 0, 0, 0); }
        }
        if (t + 1 < NT) { LAS unsigned char* nb = lds + ((t + 1) & 1) * BUFB;
            *(LAS u32x4*)(nb + krow * KS + kch * 16) = rk; *(LAS u32x4*)(nb + VOFF + krow * VS + kch * 16) = rv; if (tid < 256) *(LAS u32x4*)(nb + rrow * KS + 128 + rch * 16) = rr; }
        __syncthreads();
    }
    l += __shfl_xor(l, 16); l += __shfl_xor(l, 32);
    const float inv = 1.0f / l;
    bf16_t* op = MIX + (size_t)(q0 + wave * 16 + fr) * 1024 + h * 64 + 4 * g4;
#pragma unroll
    for (int dj = 0; dj < 4; ++dj) { u32x2 w; w.x = pk2(o[dj][0] * inv, o[dj][1] * inv); w.y = pk2(o[dj][2] * inv, o[dj][3] * inv); *(u32x2*)(op + 16 * dj) = w; }
}
__device__ __forceinline__ void phase_attn(const Params& p, LAS unsigned char* lds) {
    for (int u = blockIdx.x; u < 768; u += gridDim.x) {
        if (u < 256) { const int b = u >> 6, h = (u >> 3) & 7, qb = u & 7; attn_unit(p, lds, NCTX + b * 1024 + qb * 128, NCTX + b * 1280, 1280, h); }
        else { const int v = u - 256, b = v >> 4, h = (v >> 1) & 7, qb = v & 1; attn_unit(p, lds, b * 256 + qb * 128, b * 256, 256, h); }
    }
}

__device__ __forceinline__ void phase_post1(const Params& p) {
    int tid0_ = threadIdx.x; asm volatile("" : "+v"(tid0_)); const int tid = tid0_, lane = tid & 63, wave = tid >> 6;
    const int gw = blockIdx.x * 8 + wave, NGW = gridDim.x * 8;
    const float* MOD = (const float*)(p.ws + WS_MOD); const bf16_t* MIXO = (const bf16_t*)(p.ws + WS_MIXO); bf16_t* H = (bf16_t*)(p.ws + WS_H);
    for (int r = gw; r < MTOK; r += NGW) {
        const float* xr = xrow(p, r); const float* md = MOD + cls_of(r) * 6144; float* yr = p.out + OUT_Y + (size_t)r * D;
        float mv[16]; float s = 0.f;
#pragma unroll
        for (int j = 0; j < 2; ++j) { const u32x4 w = *(const u32x4*)(MIXO + (size_t)r * D + 8 * lane + 512 * j);
            mv[8 * j + 0] = bflo(w.x); mv[8 * j + 1] = bfhi(w.x); mv[8 * j + 2] = bflo(w.y); mv[8 * j + 3] = bfhi(w.y); mv[8 * j + 4] = bflo(w.z); mv[8 * j + 5] = bfhi(w.z); mv[8 * j + 6] = bflo(w.w); mv[8 * j + 7] = bfhi(w.w); }
#pragma unroll
        for (int e = 0; e < 16; ++e) s += mv[e] * mv[e];
        const float rs = 1.0f / sqrtf(wave_sum(s) * (1.0f / D) + EPS);
        float x1[16]; float s1 = 0.f;
#pragma unroll
        for (int j = 0; j < 2; ++j)
#pragma unroll
            for (int q = 0; q < 2; ++q) { const int col = 8 * lane + 512 * j + 4 * q;
                const f32x4 xv = *(const f32x4*)(xr + col), ga = *(const f32x4*)(md + 2048 + col), gp = *(const f32x4*)(p.g_attn_post + col);
#pragma unroll
                for (int e = 0; e < 4; ++e) { const float v = xv[e] + ga[e] * (mv[8 * j + 4 * q + e] * rs * gp[e]); x1[8 * j + 4 * q + e] = v; s1 += v * v; }
                *(f32x4*)(yr + col) = (f32x4){x1[8 * j + 4 * q], x1[8 * j + 4 * q + 1], x1[8 * j + 4 * q + 2], x1[8 * j + 4 * q + 3]}; }
        const float r1 = 1.0f / sqrtf(wave_sum(s1) * (1.0f / D) + EPS);
#pragma unroll
        for (int j = 0; j < 2; ++j) { const int col = 8 * lane + 512 * j; float hv[8];
#pragma unroll
            for (int q = 0; q < 2; ++q) { const f32x4 g = *(const f32x4*)(p.g_ffn_pre + col + 4 * q), sh = *(const f32x4*)(md + 3072 + col + 4 * q), sc = *(const f32x4*)(md + 4096 + col + 4 * q);
#pragma unroll
                for (int e = 0; e < 4; ++e) hv[4 * q + e] = x1[8 * j + 4 * q + e] * r1 * g[e] * (1.0f + sc[e]) + sh[e]; }
            u32x4 w; w.x = pk2(hv[0], hv[1]); w.y = pk2(hv[2], hv[3]); w.z = pk2(hv[4], hv[5]); w.w = pk2(hv[6], hv[7]);
            *(u32x4*)(H + (size_t)r * D + col) = w; }
    }
}
__device__ __forceinline__ void phase_final(const Params& p) {
    int tid0_ = threadIdx.x; asm volatile("" : "+v"(tid0_)); const int tid = tid0_, lane = tid & 63, wave = tid >> 6;
    const int gw = blockIdx.x * 8 + wave, NGW = gridDim.x * 8;
    const float* MOD = (const float*)(p.ws + WS_MOD); const bf16_t* F = (const bf16_t*)(p.ws + WS_F);
    for (int r = gw; r < MTOK; r += NGW) {
        const float* md = MOD + cls_of(r) * 6144; float* yr = p.out + OUT_Y + (size_t)r * D;
        float fv[16]; float s = 0.f;
#pragma unroll
        for (int j = 0; j < 2; ++j) { const u32x4 w = *(const u32x4*)(F + (size_t)r * D + 8 * lane + 512 * j);
            fv[8 * j + 0] = bflo(w.x); fv[8 * j + 1] = bfhi(w.x); fv[8 * j + 2] = bflo(w.y); fv[8 * j + 3] = bfhi(w.y); fv[8 * j + 4] = bflo(w.z); fv[8 * j + 5] = bfhi(w.z); fv[8 * j + 6] = bflo(w.w); fv[8 * j + 7] = bfhi(w.w); }
#pragma unroll
        for (int e = 0; e < 16; ++e) s += fv[e] * fv[e];
        const float rs = 1.0f / sqrtf(wave_sum(s) * (1.0f / D) + EPS);
#pragma unroll
        for (int j = 0; j < 2; ++j)
#pragma unroll
            for (int q = 0; q < 2; ++q) { const int col = 8 * lane + 512 * j + 4 * q;
                const f32x4 xv = *(const f32x4*)(yr + col), gf = *(const f32x4*)(md + 5120 + col), gp = *(const f32x4*)(p.g_ffn_post + col);
                f32x4 y;
#pragma unroll
                for (int e = 0; e < 4; ++e) y[e] = xv[e] + gf[e] * (fv[8 * j + 4 * q + e] * rs * gp[e]);
                *(f32x4*)(yr + col) = y; }
    }
}

constexpr int LDS_BYTES = 131072 + 1024;
#define GSYNC() grid.sync()
template <class Epi> __device__ __forceinline__ void run_gemm(LAS unsigned char* lds, const bf16_t* A, const bf16_t* Bt, int M, int N, int K, const Epi& E) {
    pg8::Gemm g{A, Bt, M, N, K}; pg8::StaticOrder S; S.init(M, N, (int)gridDim.x, (int)blockIdx.x);
    pg8::gemm_phase<Epi, pg8::StaticOrder, true, true>(lds, g, S, E);
}
__global__ void __launch_bounds__(512, 2) fwd_megakernel(Params p) {
    extern __shared__ __attribute__((aligned(16))) unsigned char smem[];
    LAS unsigned char* lds = (LAS unsigned char*)smem;
    cg::grid_group grid = cg::this_grid();
    unsigned char* ws = p.ws;
#ifndef PH
#define PH 0xFFFF
#endif
#if PH & 1
    phase0(p, lds);
#endif
    GSYNC();
#if PH & 2
    phase_xn(p);
#endif
    GSYNC();
#if PH & 4
    { EpiInProj E{(float*)(ws + WS_PROJ), (bf16_t*)(ws + WS_UV)}; run_gemm(lds, (const bf16_t*)(ws + WS_H), (const bf16_t*)(ws + WS_WIN), MTOK, NPROJ, 1024, E); }
#endif
    GSYNC();
#if PH & 8
    phase_prep(p);
#endif
    GSYNC();
#if PH & 16
    { EpiQ E{(bf16_t*)(ws + WS_Q), (const float*)(ws + WS_ROPE)}; run_gemm(lds, (const bf16_t*)(ws + WS_CQN), (const bf16_t*)(ws + WS_WUQ), MTOK, 768, 256, E); }
#endif
#if PH & 32
    { EpiStore<0> E{(bf16_t*)(ws + WS_KN), 512}; run_gemm(lds, (const bf16_t*)(ws + WS_CKVN), (const bf16_t*)(ws + WS_WK), NKV, 512, 128, E); }
    { EpiStore<0> E{(bf16_t*)(ws + WS_VT), NKV}; run_gemm(lds, (const bf16_t*)(ws + WS_WV), (const bf16_t*)(ws + WS_CKVN), 512, NKV, 128, E); }
#endif
    __syncthreads();
#if PH & 64
    for (int u = blockIdx.x; u < 768; u += gridDim.x) sgu_unit(p, lds, u >> 3, u & 7);
#endif
    GSYNC();
#if PH & 128
    phase_attn(p, lds);
#endif
    GSYNC();
#if PH & 256
    { EpiStore<0> E{(bf16_t*)(ws + WS_MIXO), 1024}; run_gemm(lds, (const bf16_t*)(ws + WS_MIX), (const bf16_t*)(ws + WS_WO), MTOK, 1024, 1024, E); }
#endif
    GSYNC();
#if PH & 512
    phase_post1(p);
#endif
    GSYNC();
#if PH & 1024
    { EpiStore<1> E{(bf16_t*)(ws + WS_A1), DFF}; run_gemm(lds, (const bf16_t*)(ws + WS_H), (const bf16_t*)(ws + WS_W1), MTOK, DFF, 1024, E); }
#endif
    GSYNC();
#if PH & 2048
    { EpiStore<0> E{(bf16_t*)(ws + WS_F), 1024}; run_gemm(lds, (const bf16_t*)(ws + WS_A1), (const bf16_t*)(ws + WS_W2), MTOK, 1024, DFF, E); }
#endif
    GSYNC();
#if PH & 4096
    phase_final(p);
#endif
}

extern "C" void kernel_launch(void* const* d_in, const int* in_sizes, int n_in, void* d_out, int out_size, void* d_ws, size_t ws_size, hipStream_t stream) {
    static int grid_blocks = 0;
    if (grid_blocks == 0) {
        if (n_in != 24 || ws_size < WS_END) { fprintf(stderr, "kernel_launch: unexpected n_in %d / ws %zu\n", n_in, ws_size); grid_blocks = -1; return; }
        int dev = 0, cus = 0, per_cu = 0;
        hipGetDevice(&dev); hipDeviceGetAttribute(&cus, hipDeviceAttributeMultiprocessorCount, dev);
        hipFuncSetAttribute((const void*)fwd_megakernel, hipFuncAttributeMaxDynamicSharedMemorySize, LDS_BYTES);
        hipOccupancyMaxActiveBlocksPerMultiprocessor(&per_cu, (const void*)fwd_megakernel, 512, LDS_BYTES);
        if (per_cu < 1) { fprintf(stderr, "kernel_launch: occupancy query says %d\n", per_cu); per_cu = 1; }
        grid_blocks = cus;
        (void)hipGetLastError();
    }
    if (grid_blocks < 0) return;
    Params p{};
    const float** pp = (const float**)&p;
    for (int i = 0; i < 24; ++i) pp[i] = (const float*)d_in[i];
    p.out = (float*)d_out; p.ws = (unsigned char*)d_ws;
    void* args[] = {&p};
    hipError_t e = hipLaunchCooperativeKernel((void*)fwd_megakernel, dim3(grid_blocks), dim3(512), args, LDS_BYTES, stream);
    if (e != hipSuccess) fprintf(stderr, "cooperative launch failed: %s (grid %d)\n", hipGetErrorString(e), grid_blocks);
}
```

```cpp
#include <hip/hip_runtime.h>
#include <hip/hip_cooperative_groups.h>
#include <cstdio>
#include <cstdint>
namespace cg = cooperative_groups;
namespace pg8 {
#define PG8_LAS __attribute__((address_space(3)))
typedef unsigned short bf16_t;
typedef short bf16x8 __attribute__((ext_vector_type(8)));
typedef float f32x4 __attribute__((ext_vector_type(4)));
typedef unsigned u32x4 __attribute__((ext_vector_type(4)));
constexpr int BM = 256, BK = 64, HALF = 128, HTB = HALF * BK * 2  , STAGE_BYTES = 8 * HTB, NXCD = 8, WGM = 8;

__host__ __device__ __forceinline__ int lds_byte(int r, int c) { const int st = (r >> 4) * 2 + (c >> 5), rr = r & 15, cc = c & 31, ob = rr * 64 + cc * 2; return st * 1024 + (ob ^ (((ob >> 9) & 1) << 5)); }
__host__ __device__ __forceinline__ void stage_rc(int b, int& R, int& C) { const int st = b / 1024, sb = b % 1024, swz = sb ^ (((sb >> 9) & 1) << 5); R = (st >> 1) * 16 + swz / 64; C = (st & 1) * 32 + (swz % 64) / 2; }
__host__ __device__ __forceinline__ int perm32(int rho) { const int n = rho >> 4, i = rho & 15; return 8 * (i >> 2) + 4 * n + (i & 3); }

struct Unit { int pm, pn; };
struct Gemm { const bf16_t* A; const bf16_t* Bt; int M, N, K; };

struct StaticOrder {
    int nM, nN, nwg, G, c;
    __host__ __device__ void init(int M, int N, int G_, int c_) { nM = M / BM; nN = N / BM; nwg = nM * nN; G = G_; c = c_; }
    __host__ __device__ bool next(int i, Unit& u) const {
        const long L = (long)i * G + c; if (L >= nwg) return false;
        int wgid = (int)L; { const int q = nwg / NXCD, r = nwg % NXCD, xcd = wgid % NXCD, off = wgid / NXCD; wgid = (xcd < r ? xcd * (q + 1) : r * (q + 1) + (xcd - r) * q) + off; }
        const int nig = WGM * nN, gid = wgid / nig, fm = gid * WGM, gsz = (nM - fm) < WGM ? (nM - fm) : WGM;
        u.pm = fm + ((wgid % nig) % gsz); u.pn = (wgid % nig) / gsz; return true;
    }
    __device__ __forceinline__ void a_ready(const Unit&) const {}
    __device__ __forceinline__ void done(const Unit&) const {}
};

__device__ __forceinline__ unsigned cvt_pk_bf16(float lo, float hi) { unsigned r; asm volatile("v_cvt_pk_bf16_f32 %0, %1, %2" : "=v"(r) : "v"(lo), "v"(hi)); return r; }
typedef float f32x2 __attribute__((ext_vector_type(2)));
template <class Epi, class Sched, bool ALIGN_EPI = false, bool SP2 = false>
__device__ __forceinline__ void gemm_phase(PG8_LAS unsigned char* lds, const Gemm g, const Sched& S, const Epi& E) {
    int tid0_ = threadIdx.x; asm volatile("" : "+v"(tid0_)); const int tid = tid0_, wid = __builtin_amdgcn_readfirstlane(tid >> 6), lane = tid & 63, wr = wid >> 2, wc = wid & 3, fr = lane & 15, fq = lane >> 4;
    const int K = g.K, nt = K / BK;
    unsigned voffA[2], voffB[2];
#pragma unroll
    for (int i = 0; i < 2; ++i) { int R, C; stage_rc(tid * 16 + i * 8192, R, C); const int Rb = Epi::PERM ? ((R & ~31) + perm32(R & 31)) : R;
        voffA[i] = (unsigned)(R * K + C) * 2u; voffB[i] = (unsigned)(Rb * K + C) * 2u; }
    const size_t kstep = (size_t)(BK * 2);
    const size_t hstep = (size_t)HALF * K * 2;
    const size_t tstep = 2 * hstep;
    const unsigned ldsw = (unsigned)wid * 1024u;
    const int aoff = lds_byte(wr * 64 + fr, fq * 8), boff = lds_byte(wc * 32 + fr, fq * 8);
#define PG8_SA(b, h) (((b) * 2 + (h)) * HTB)
#define PG8_SB(b, h) ((4 + (b) * 2 + (h)) * HTB)
#define PG8_STAGE(bufoff, gbase, voff) do { _Pragma("unroll") for (int _i = 0; _i < 2; ++_i) \
        __builtin_amdgcn_global_load_lds((const unsigned*)((const char*)(gbase) + (voff)[_i]), (PG8_LAS unsigned*)(lds + (bufoff) + ldsw + _i * 8192), 16, 0, 0); } while (0)
#define PG8_LDA(dst, b, h) do { _Pragma("unroll") for (int m = 0; m < 4; ++m) _Pragma("unroll") for (int k = 0; k < 2; ++k) dst[m][k] = *(const PG8_LAS bf16x8*)(lds + PG8_SA(b, h) + aoff + m * 2048 + k * 1024); } while (0)
#define PG8_LDB(dst, b, h) do { _Pragma("unroll") for (int n = 0; n < 2; ++n) _Pragma("unroll") for (int k = 0; k < 2; ++k) dst[n][k] = *(const PG8_LAS bf16x8*)(lds + PG8_SB(b, h) + boff + n * 2048 + k * 1024); } while (0)
#define PG8_MMA(ai, bj, At, Bt) do { __builtin_amdgcn_s_setprio(1); _Pragma("unroll") for (int m = 0; m < 4; ++m) _Pragma("unroll") for (int n = 0; n < 2; ++n) _Pragma("unroll") for (int k = 0; k < 2; ++k) \
        acc[ai][bj][m][n] = __builtin_amdgcn_mfma_f32_16x16x32_bf16(Bt[n][k], At[m][k], acc[ai][bj][m][n], 0, 0, 0); __builtin_amdgcn_s_setprio(0); } while (0)
#define PG8_WAIT_V(n) asm volatile("s_waitcnt vmcnt(" #n ")" ::: "memory")
#define PG8_WAIT_L(n) asm volatile("s_waitcnt lgkmcnt(" #n ")" ::: "memory")
#define PG8_BAR __builtin_amdgcn_s_barrier()
#define PG8_SCHED __builtin_amdgcn_sched_barrier(0)
    Unit cur, nxt; int ui = 0;
    if (!S.next(0, cur)) return;
    f32x4 acc[2][2][4][2];
#pragma unroll
    for (int a = 0; a < 2; ++a)
#pragma unroll
        for (int b = 0; b < 2; ++b)
#pragma unroll
            for (int m = 0; m < 4; ++m)
#pragma unroll
                for (int n = 0; n < 2; ++n) acc[a][b][m][n] = (f32x4){0.f, 0.f, 0.f, 0.f};
    bf16x8 At[4][2], B0[2][2], B1[2][2];
    const char* cA = (const char*)g.A + (size_t)cur.pm * tstep; const char* cB = (const char*)g.Bt + (size_t)cur.pn * tstep;
    S.a_ready(cur);
    if constexpr (SP2) {
        PG8_STAGE(PG8_SB(0, 0), cB, voffB); PG8_STAGE(PG8_SB(0, 1), cB + hstep, voffB); PG8_STAGE(PG8_SA(0, 0), cA, voffA); PG8_STAGE(PG8_SA(0, 1), cA + hstep, voffA);
        if (wr == 1) PG8_BAR;
        PG8_WAIT_V(2); PG8_BAR;
        PG8_STAGE(PG8_SB(1, 0), cB + kstep, voffB); PG8_STAGE(PG8_SA(1, 0), cA + kstep, voffA); PG8_STAGE(PG8_SB(1, 1), cB + hstep + kstep, voffB);
        PG8_WAIT_V(6); PG8_BAR;
    } else {
        PG8_STAGE(PG8_SB(0, 0), cB, voffB); PG8_STAGE(PG8_SA(0, 0), cA, voffA); PG8_STAGE(PG8_SB(0, 1), cB + hstep, voffB); PG8_STAGE(PG8_SA(0, 1), cA + hstep, voffA);
        if (wr == 1) PG8_BAR;
        PG8_WAIT_V(4); PG8_BAR;
        PG8_STAGE(PG8_SB(1, 0), cB + kstep, voffB); PG8_STAGE(PG8_SA(1, 0), cA + kstep, voffA); PG8_STAGE(PG8_SB(1, 1), cB + hstep + kstep, voffB);
        PG8_WAIT_V(6); PG8_BAR;
    }
    for (;;) {
        const bool has_next = S.next(ui + 1, nxt);
        const char* nA = has_next ? (const char*)g.A + (size_t)nxt.pm * tstep : cA; const char* nB = has_next ? (const char*)g.Bt + (size_t)nxt.pn * tstep : cB;
        for (int t = 0; t < nt; t += 2) {
            const bool last = (t == nt - 2);
            const char* a1 = cA + (size_t)(t + 1) * kstep;
            const char* a2 = last ? nA : cA + (size_t)(t + 2) * kstep; const char* b2 = last ? nB : cB + (size_t)(t + 2) * kstep;
            const char* a3 = a2 + kstep; const char* b3 = b2 + kstep;
            if (last && has_next) S.a_ready(nxt);
            if constexpr (SP2) {
            PG8_LDB(B0, 0, 0); PG8_LDB(B1, 0, 1); PG8_SCHED; PG8_LDA(At, 0, 0); PG8_STAGE(PG8_SA(1, 1), a1 + hstep, voffA);
            PG8_WAIT_V(8); PG8_WAIT_L(0); PG8_BAR; PG8_MMA(0, 0, At, B0); PG8_MMA(0, 1, At, B1); PG8_BAR; PG8_SCHED;
            PG8_LDA(At, 0, 1); PG8_STAGE(PG8_SB(0, 0), b2, voffB); PG8_STAGE(PG8_SB(0, 1), b2 + hstep, voffB); PG8_STAGE(PG8_SA(0, 0), a2, voffA);
            PG8_WAIT_V(8); PG8_WAIT_L(0); PG8_BAR; PG8_MMA(1, 0, At, B0); PG8_MMA(1, 1, At, B1); PG8_BAR; PG8_SCHED;
            PG8_LDB(B0, 1, 0); PG8_LDB(B1, 1, 1); PG8_SCHED; PG8_LDA(At, 1, 0); PG8_STAGE(PG8_SA(0, 1), a2 + hstep, voffA);
            PG8_WAIT_V(8); PG8_WAIT_L(0); PG8_BAR; PG8_MMA(0, 0, At, B0); PG8_MMA(0, 1, At, B1); PG8_BAR; PG8_SCHED;
            PG8_LDA(At, 1, 1); PG8_STAGE(PG8_SB(1, 0), b3, voffB); PG8_STAGE(PG8_SB(1, 1), b3 + hstep, voffB); PG8_STAGE(PG8_SA(1, 0), a3, voffA);
            PG8_WAIT_V(8); PG8_WAIT_L(0); PG8_BAR; PG8_MMA(1, 0, At, B0); PG8_MMA(1, 1, At, B1); PG8_BAR; PG8_SCHED;
            } else {
            PG8_LDB(B0, 0, 0); PG8_SCHED; PG8_LDA(At, 0, 0); PG8_STAGE(PG8_SA(1, 1), a1 + hstep, voffA);
            PG8_WAIT_L(8); PG8_BAR; PG8_WAIT_L(0); PG8_MMA(0, 0, At, B0); PG8_BAR; PG8_SCHED;
            PG8_LDB(B1, 0, 1); PG8_STAGE(PG8_SB(0, 0), b2, voffB);
            PG8_BAR; PG8_WAIT_L(0); PG8_MMA(0, 1, At, B1); PG8_BAR;
            PG8_LDA(At, 0, 1); PG8_STAGE(PG8_SA(0, 0), a2, voffA);
            PG8_BAR; PG8_WAIT_L(0); PG8_MMA(1, 0, At, B0); PG8_BAR; PG8_SCHED;
            PG8_STAGE(PG8_SB(0, 1), b2 + hstep, voffB);
            PG8_WAIT_V(6); PG8_BAR; PG8_MMA(1, 1, At, B1); PG8_BAR;
            PG8_LDB(B0, 1, 0); PG8_SCHED; PG8_LDA(At, 1, 0); PG8_STAGE(PG8_SA(0, 1), a2 + hstep, voffA);
            PG8_WAIT_L(8); PG8_BAR; PG8_WAIT_L(0); PG8_MMA(0, 0, At, B0); PG8_BAR; PG8_SCHED;
            PG8_LDB(B1, 1, 1); PG8_STAGE(PG8_SB(1, 0), b3, voffB);
            PG8_BAR; PG8_WAIT_L(0); PG8_MMA(0, 1, At, B1); PG8_BAR;
            PG8_LDA(At, 1, 1); PG8_STAGE(PG8_SA(1, 0), a3, voffA);
            PG8_BAR; PG8_WAIT_L(0); PG8_MMA(1, 0, At, B0); PG8_BAR; PG8_SCHED;
            PG8_STAGE(PG8_SB(1, 1), b3 + hstep, voffB);
            PG8_WAIT_V(6); PG8_BAR; PG8_MMA(1, 1, At, B1); PG8_BAR;
            }
        }
        if constexpr (ALIGN_EPI) { if (wr == 0) PG8_BAR; }
        if constexpr (!Epi::AFTER_DRAIN) { E(acc, cur, wr, wc, fr, fq); S.done(cur); }
        if (!has_next) break;
#pragma unroll
        for (int a = 0; a < 2; ++a)
#pragma unroll
            for (int b = 0; b < 2; ++b)
#pragma unroll
                for (int m = 0; m < 4; ++m)
#pragma unroll
                    for (int n = 0; n < 2; ++n) acc[a][b][m][n] = (f32x4){0.f, 0.f, 0.f, 0.f};
        cur = nxt; cA = nA; cB = nB; ++ui;
        if constexpr (ALIGN_EPI) { if (wr == 1) PG8_BAR; }
    }
    PG8_WAIT_V(0);
    if constexpr (!ALIGN_EPI) { if (wr == 0) PG8_BAR; }
    PG8_BAR;
    if constexpr (Epi::AFTER_DRAIN) { E.fused(acc, cur, wr, wc, fr, fq, lds, wid, lane); S.done(cur); }
#undef PG8_SA
#undef PG8_SB
#undef PG8_STAGE
#undef PG8_LDA
#undef PG8_LDB
#undef PG8_MMA
#undef PG8_WAIT_V
#undef PG8_WAIT_L
#undef PG8_BAR
#undef PG8_SCHED
}
}
#define LAS __attribute__((address_space(3)))
typedef unsigned short bf16_t;
typedef short bf16x8 __attribute__((ext_vector_type(8)));
typedef float f32x4 __attribute__((ext_vector_type(4)));
typedef float f32x2 __attribute__((ext_vector_type(2)));
typedef unsigned u32x4 __attribute__((ext_vector_type(4)));
typedef unsigned u32x2 __attribute__((ext_vector_type(2)));
using pg8::cvt_pk_bf16;

constexpr int D = 1024, NCTX = 8192, NLAT = 4096, MTOK = 12288, NKV = 13312;
constexpr int NPROJ = 1536;
constexpr int DFF = 4096;
constexpr float EPS = 1e-6f;
constexpr float QSCALE = 0.10206207261596575f * 1.4426950408889634f;

constexpr size_t MiB = 1u << 20;
constexpr size_t WS_BAR = 176 * MiB;
constexpr size_t WS_MOD = 0;
constexpr size_t WS_ROPE = 128 * 1024;
constexpr size_t WS_VSTAT = 256 * 1024;
constexpr size_t WS_WUQ = 512 * 1024;
constexpr size_t WS_WK = 896 * 1024;
constexpr size_t WS_WV = 1024 * 1024;
constexpr size_t WS_WSGU = 1152 * 1024;
constexpr size_t WS_WIN = 2 * MiB;
constexpr size_t WS_WO = 5 * MiB;
constexpr size_t WS_W1 = 7 * MiB;
constexpr size_t WS_W2 = 15 * MiB;
constexpr size_t WS_H = 24 * MiB;
constexpr size_t WS_UV = 48 * MiB;
constexpr size_t WS_F = WS_UV;
constexpr size_t WS_PROJ = 72 * MiB;
constexpr size_t WS_MIXO = WS_PROJ;
constexpr size_t WS_CQN = 96 * MiB;
constexpr size_t WS_CKVN = 102 * MiB;
constexpr size_t WS_KR = 106 * MiB;
constexpr size_t WS_Q = 107 * MiB;
constexpr size_t WS_KN = 125 * MiB;
constexpr size_t WS_VT = 138 * MiB;
constexpr size_t WS_MIX = 151 * MiB;
constexpr size_t WS_A1 = 72 * MiB;
constexpr size_t WS_END = 177 * MiB;

constexpr size_t OUT_Y = 0, OUT_CKV = (size_t)MTOK * D, OUT_KR = OUT_CKV + (size_t)NCTX * 128;

struct Params {
    const float *x_prompt, *x_sample, *cache_ckv, *cache_krope, *c, *c_ctx, *w_mod, *b_mod, *g_attn_pre, *g_attn_post, *w_in, *g_q, *w_uq, *g_kv, *w_ukv,
        *w_sgu, *b_sgu, *g_sgu, *beta_sgu, *w_o, *g_ffn_pre, *g_ffn_post, *w_ff1, *w_ff2;
    float* out; unsigned char* ws;
};

__device__ __forceinline__ float bf2f(unsigned short b) { return __uint_as_float((unsigned)b << 16); }
__device__ __forceinline__ float bflo(unsigned w) { return __uint_as_float(w << 16); }
__device__ __forceinline__ float bfhi(unsigned w) { return __uint_as_float(w & 0xffff0000u); }
__device__ __forceinline__ float wave_sum(float v) {
#pragma unroll
    for (int o = 1; o < 64; o <<= 1) v += __shfl_xor(v, o);
    return v;
}
__device__ __forceinline__ const float* xrow(const Params& p, int r) { return r < NCTX ? p.x_prompt + (size_t)r * D : p.x_sample + (size_t)(r - NCTX) * D; }
__device__ __forceinline__ int cls_of(int r) { return r < NCTX ? 0 : 1 + ((r - NCTX) >> 10); }
__device__ __forceinline__ int kvrow_of(int r) { return r < NCTX ? r : NCTX + ((r - NCTX) >> 10) * 1280 + 256 + ((r - NCTX) & 1023); }
__device__ __forceinline__ float gelu_tanh(float x) {
    const float u = 0.7978845608028654f * (x + 0.044715f * x * x * x);
    return x / (1.0f + __builtin_amdgcn_exp2f(-2.0f * 1.4426950408889634f * u));
}

template <int ACT  > struct EpiStore {
    static constexpr bool PERM = true, AFTER_DRAIN = false;
    bf16_t* O; int ldc;
    __device__ __forceinline__ void operator()(const f32x4 (&acc)[2][2][4][2], const pg8::Unit& u, int wr, int wc, int fr, int fq) const {
        const int row0 = u.pm * 256 + wr * 64 + fr, col0 = u.pn * 256 + wc * 32 + 8 * fq;
#pragma unroll
        for (int ai = 0; ai < 2; ++ai)
#pragma unroll
            for (int m = 0; m < 4; ++m) { bf16_t* rowp = O + (size_t)(row0 + ai * 128 + m * 16) * ldc + col0;
#pragma unroll
                for (int bj = 0; bj < 2; ++bj) { f32x4 v0 = acc[ai][bj][m][0], v1 = acc[ai][bj][m][1];
                    if (ACT == 1) {
#pragma unroll
                        for (int e = 0; e < 4; ++e) { float a = fmaxf(v0[e], 0.f), b = fmaxf(v1[e], 0.f); v0[e] = a * a; v1[e] = b * b; } }
                    u32x4 w; w.x = cvt_pk_bf16(v0[0], v0[1]); w.y = cvt_pk_bf16(v0[2], v0[3]); w.z = cvt_pk_bf16(v1[0], v1[1]); w.w = cvt_pk_bf16(v1[2], v1[3]);
                    *(u32x4*)(rowp + bj * 128) = w; } }
    }
};
struct EpiInProj {
    static constexpr bool PERM = true, AFTER_DRAIN = false;
    float* PROJ; bf16_t* UV;
    __device__ __forceinline__ void operator()(const f32x4 (&acc)[2][2][4][2], const pg8::Unit& u, int wr, int wc, int fr, int fq) const {
        const int row0 = u.pm * 256 + wr * 64 + fr, colt = wc * 32 + 8 * fq;
        if (u.pn < 2) {
#pragma unroll
            for (int ai = 0; ai < 2; ++ai)
#pragma unroll
                for (int m = 0; m < 4; ++m) { float* rowp = PROJ + (size_t)(row0 + ai * 128 + m * 16) * 512 + u.pn * 256 + colt;
#pragma unroll
                    for (int bj = 0; bj < 2; ++bj) { *(f32x4*)(rowp + bj * 128) = acc[ai][bj][m][0]; *(f32x4*)(rowp + bj * 128 + 4) = acc[ai][bj][m][1]; } }
        } else {
#pragma unroll
            for (int ai = 0; ai < 2; ++ai)
#pragma unroll
                for (int m = 0; m < 4; ++m) { bf16_t* rowp = UV + (size_t)(row0 + ai * 128 + m * 16) * 1024 + (u.pn - 2) * 256 + colt;
#pragma unroll
                    for (int bj = 0; bj < 2; ++bj) { f32x4 v0 = acc[ai][bj][m][0], v1 = acc[ai][bj][m][1];
#pragma unroll
                        for (int e = 0; e < 4; ++e) { v0[e] = gelu_tanh(v0[e]); v1[e] = gelu_tanh(v1[e]); }
                        u32x4 w; w.x = cvt_pk_bf16(v0[0], v0[1]); w.y = cvt_pk_bf16(v0[2], v0[3]); w.z = cvt_pk_bf16(v1[0], v1[1]); w.w = cvt_pk_bf16(v1[2], v1[3]);
                        *(u32x4*)(rowp + bj * 128) = w; } }
        }
    }
};
struct EpiQ {
    static constexpr bool PERM = true, AFTER_DRAIN = false;
    bf16_t* Q; const float* rope;
    __device__ __forceinline__ void operator()(const f32x4 (&acc)[2][2][4][2], const pg8::Unit& u, int wr, int wc, int fr, int fq) const {
        const int row0 = u.pm * 256 + wr * 64 + fr, col0 = u.pn * 256 + wc * 32 + 8 * fq;
        const bool lat = (u.pm * 256) >= NCTX;
#pragma unroll
        for (int ai = 0; ai < 2; ++ai)
#pragma unroll
            for (int m = 0; m < 4; ++m) { const int row = row0 + ai * 128 + m * 16; bf16_t* rowp = Q + (size_t)row * 768 + col0;
#pragma unroll
                for (int bj = 0; bj < 2; ++bj) { f32x4 v0 = acc[ai][bj][m][0], v1 = acc[ai][bj][m][1];
                    const int hc = (col0 + bj * 128) % 96;
                    if (lat && hc >= 64) { const int t = (row - NCTX) & 1023; const f32x4* rp = (const f32x4*)(rope + (size_t)t * 32 + (hc - 64));
                        const f32x4 r0 = rp[0], r1 = rp[1];
                        f32x4 o0, o1;
                        o0[0] = v0[0] * r0[0] - v0[1] * r0[1]; o0[1] = v0[0] * r0[1] + v0[1] * r0[0];
                        o0[2] = v0[2] * r0[2] - v0[3] * r0[3]; o0[3] = v0[2] * r0[3] + v0[3] * r0[2];
                        o1[0] = v1[0] * r1[0] - v1[1] * r1[1]; o1[1] = v1[0] * r1[1] + v1[1] * r1[0];
                        o1[2] = v1[2] * r1[2] - v1[3] * r1[3]; o1[3] = v1[2] * r1[3] + v1[3] * r1[2];
                        v0 = o0; v1 = o1; }
                    v0 = v0 * QSCALE; v1 = v1 * QSCALE;
                    u32x4 w; w.x = cvt_pk_bf16(v0[0], v0[1]); w.y = cvt_pk_bf16(v0[2], v0[3]); w.z = cvt_pk_bf16(v1[0], v1[1]); w.w = cvt_pk_bf16(v1[2], v1[3]);
                    *(u32x4*)(rowp + bj * 128) = w; } }
    }
};

__device__ __forceinline__ unsigned pk2(float lo, float hi) { return cvt_pk_bf16(lo, hi); }
__device__ __forceinline__ void transpose_item(const float* W, int K, int N, bf16_t* WT, int k0, int n0, int dst_row0, LAS float* scr, int lane) {
#pragma unroll 8
    for (int i = 0; i < 32; ++i) { const int kk = 2 * i + (lane >> 5); scr[kk * 33 + (lane & 31)] = W[(size_t)(k0 + kk) * N + n0 + (lane & 31)]; }
    asm volatile("s_waitcnt lgkmcnt(0)" ::: "memory");
    const int c = lane & 7;
#pragma unroll
    for (int j = 0; j < 4; ++j) { const int n = (lane >> 3) + 8 * j; const LAS float* s = scr + (8 * c) * 33 + n;
        u32x4 o; o.x = pk2(s[0 * 33], s[1 * 33]); o.y = pk2(s[2 * 33], s[3 * 33]); o.z = pk2(s[4 * 33], s[5 * 33]); o.w = pk2(s[6 * 33], s[7 * 33]);
        *(u32x4*)(WT + (size_t)(dst_row0 + n) * K + k0 + 8 * c) = o; }
    asm volatile("s_waitcnt lgkmcnt(0)" ::: "memory");
}
__device__ __forceinline__ void phase0(const Params& p, LAS unsigned char* lds) {
    int tid0_ = threadIdx.x; asm volatile("" : "+v"(tid0_)); const int tid = tid0_, lane = tid & 63, wave = tid >> 6, G = gridDim.x;
    unsigned char* ws = p.ws;
    float* MOD = (float*)(ws + WS_MOD);
    for (int s = blockIdx.x; s < 192; s += G) {
        LAS float* sl = (LAS float*)lds; LAS float* red = sl + 5 * 1024;
        for (int e = tid; e < 5 * 1024; e += 512) { const int i = e >> 10, k = e & 1023; const float v = (i == 0) ? p.c_ctx[k] : p.c[(i - 1) * 1024 + k]; sl[e] = v / (1.0f + expf(-v)); }
        __syncthreads();
        const int col = tid & 31, kg = tid >> 5;
        float a0 = 0.f, a1 = 0.f, a2 = 0.f, a3 = 0.f, a4 = 0.f;
        const float* w = p.w_mod + (size_t)(kg * 64) * 6144 + s * 32 + col;
#pragma unroll 8
        for (int kk = 0; kk < 64; ++kk) { const float wv = w[(size_t)kk * 6144]; const int k = kg * 64 + kk;
            a0 += sl[k] * wv; a1 += sl[1024 + k] * wv; a2 += sl[2048 + k] * wv; a3 += sl[3072 + k] * wv; a4 += sl[4096 + k] * wv; }
        red[(kg * 5 + 0) * 32 + col] = a0; red[(kg * 5 + 1) * 32 + col] = a1; red[(kg * 5 + 2) * 32 + col] = a2; red[(kg * 5 + 3) * 32 + col] = a3; red[(kg * 5 + 4) * 32 + col] = a4;
        __syncthreads();
        if (tid < 160) { const int i = tid >> 5, cc = tid & 31; float sum = p.b_mod[s * 32 + cc];
#pragma unroll
            for (int g = 0; g < 16; ++g) sum += red[(g * 5 + i) * 32 + cc];
            MOD[i * 6144 + s * 32 + cc] = sum; }
        __syncthreads();
    }
    {
        LAS float* scr = (LAS float*)(lds + wave * 16384);
        const int gw = blockIdx.x * 8 + wave, NGW = G * 8;
        constexpr int I_IN = 16 * 45, I_UQ = 4 * 24, I_UKV = 2 * 32, I_O = 16 * 32, I_1 = 16 * 128, I_2 = 64 * 32;
        constexpr int NIT = I_IN + I_UQ + I_UKV + I_O + I_1 + I_2;
        for (int it = gw; it < NIT; it += NGW) {
            int r = it;
            if (r < I_IN) { const int kb = r / 45, nb = r % 45, n0 = nb * 32; transpose_item(p.w_in, 1024, 1440, (bf16_t*)(ws + WS_WIN), kb * 64, n0, n0 < 416 ? n0 : n0 + 96, scr, lane); continue; } r -= I_IN;
            if (r < I_UQ) { const int kb = r / 24, nb = r % 24; transpose_item(p.w_uq, 256, 768, (bf16_t*)(ws + WS_WUQ), kb * 64, nb * 32, nb * 32, scr, lane); continue; } r -= I_UQ;
            if (r < I_UKV) { const int kb = r / 32, nb = r % 32, n0 = nb * 32, h = n0 >> 7, wi = n0 & 127;
                if (wi < 64) transpose_item(p.w_ukv, 128, 1024, (bf16_t*)(ws + WS_WK), kb * 64, n0, h * 64 + wi, scr, lane);
                else transpose_item(p.w_ukv, 128, 1024, (bf16_t*)(ws + WS_WV), kb * 64, n0, h * 64 + wi - 64, scr, lane);
                continue; } r -= I_UKV;
            if (r < I_O) { const int kb = r / 32, nb = r % 32; transpose_item(p.w_o, 1024, 1024, (bf16_t*)(ws + WS_WO), kb * 64, nb * 32, nb * 32, scr, lane); continue; } r -= I_O;
            if (r < I_1) { const int kb = r / 128, nb = r % 128; transpose_item(p.w_ff1, 1024, 4096, (bf16_t*)(ws + WS_W1), kb * 64, nb * 32, nb * 32, scr, lane); continue; } r -= I_1;
            { const int kb = r / 32, nb = r % 32; transpose_item(p.w_ff2, 4096, 1024, (bf16_t*)(ws + WS_W2), kb * 64, nb * 32, nb * 32, scr, lane); }
        }
    }
    {
        const int gt = blockIdx.x * 512 + tid, NGT = G * 512;
        bf16_t* wsgu = (bf16_t*)(ws + WS_WSGU);
        for (int e = gt; e < 8 * 128 * 128 / 2; e += NGT) ((unsigned*)wsgu)[e] = pk2(p.w_sgu[2 * e], p.w_sgu[2 * e + 1]);
        unsigned* pad = (unsigned*)((bf16_t*)(ws + WS_WIN) + (size_t)416 * 1024);
        for (int e = gt; e < 96 * 1024 / 2; e += NGT) pad[e] = 0u;
        float* rope = (float*)(ws + WS_ROPE);
        for (int e = gt; e < 1024 * 16; e += NGT) { const int t = e >> 4, i = e & 15, j = i & 7; const float pos = (float)((i < 8) ? (t >> 6) : (t & 63));
            const float freq = 1.0f / powf(10000.0f, (float)j * 0.125f); const float ang = pos * freq; float sn, cs; sincosf(ang, &sn, &cs); rope[2 * e] = cs; rope[2 * e + 1] = sn; }
    }
}

__device__ __forceinline__ void phase_xn(const Params& p) {
    int tid0_ = threadIdx.x; asm volatile("" : "+v"(tid0_)); const int tid = tid0_, lane = tid & 63, wave = tid >> 6;
    const int gw = blockIdx.x * 8 + wave, NGW = gridDim.x * 8;
    const float* MOD = (const float*)(p.ws + WS_MOD); bf16_t* H = (bf16_t*)(p.ws + WS_H);
    for (int r = gw; r < MTOK; r += NGW) {
        const f32x4* xr = (const f32x4*)xrow(p, r) + lane; const float* md = MOD + cls_of(r) * 6144;
        f32x4 v[4]; float s = 0.f;
#pragma unroll
        for (int j = 0; j < 4; ++j) { v[j] = xr[64 * j]; s += (v[j][0] * v[j][0] + v[j][1] * v[j][1]) + (v[j][2] * v[j][2] + v[j][3] * v[j][3]); }
        const float rstd = 1.0f / sqrtf(wave_sum(s) * (1.0f / D) + EPS);
#pragma unroll
        for (int j = 0; j < 4; ++j) { const int col = 4 * lane + 256 * j;
            const f32x4 g = *(const f32x4*)(p.g_attn_pre + col), sh = *(const f32x4*)(md + col), sc = *(const f32x4*)(md + 1024 + col);
            const f32x4 o = v[j] * rstd * g * (sc + 1.0f) + sh;
            u32x2 w; w.x = pk2(o[0], o[1]); w.y = pk2(o[2], o[3]); *(u32x2*)(H + (size_t)r * D + col) = w; }
    }
}

__device__ __forceinline__ void phase_prep(const Params& p) {
    int tid0_ = threadIdx.x; asm volatile("" : "+v"(tid0_)); const int tid = tid0_, lane = tid & 63, wave = tid >> 6;
    const int gw = blockIdx.x * 8 + wave, NGW = gridDim.x * 8;
    unsigned char* ws = p.ws;
    const float* PROJ = (const float*)(ws + WS_PROJ); const bf16_t* UV = (const bf16_t*)(ws + WS_UV);
    bf16_t* CQN = (bf16_t*)(ws + WS_CQN); bf16_t* CKVN = (bf16_t*)(ws + WS_CKVN); bf16_t* KR = (bf16_t*)(ws + WS_KR);
    float* VSTAT = (float*)(ws + WS_VSTAT); const float* rope = (const float*)(ws + WS_ROPE);
    for (int r = gw; r < MTOK + 1024; r += NGW) {
        if (r >= MTOK) {
            const int j = r - MTOK, b = j >> 8, pp = j & 255; const size_t kvr = (size_t)NCTX + b * 1280 + pp;
            const f32x2 cv = *(const f32x2*)(p.cache_ckv + (size_t)j * 128 + 2 * lane);
            *(unsigned*)(CKVN + kvr * 128 + 2 * lane) = pk2(cv[0], cv[1]);
            if (lane < 16) { const f32x2 kv = *(const f32x2*)(p.cache_krope + (size_t)j * 32 + 2 * lane); *(unsigned*)(KR + kvr * 32 + 2 * lane) = pk2(kv[0], kv[1]); }
            continue;
        }
        const float* pr = PROJ + (size_t)r * 512; const size_t kvr = (size_t)kvrow_of(r);
        { const f32x4 v = *(const f32x4*)(pr + 4 * lane); const float s = wave_sum((v[0] * v[0] + v[1] * v[1]) + (v[2] * v[2] + v[3] * v[3]));
          const float rstd = 1.0f / sqrtf(s * (1.0f / 256.0f) + EPS); const f32x4 g = *(const f32x4*)(p.g_q + 4 * lane); const f32x4 o = v * rstd * g;
          u32x2 w; w.x = pk2(o[0], o[1]); w.y = pk2(o[2], o[3]); *(u32x2*)(CQN + (size_t)r * 256 + 4 * lane) = w; }
        { const f32x2 v = *(const f32x2*)(pr + 256 + 2 * lane); const float s = wave_sum(v[0] * v[0] + v[1] * v[1]);
          const float rstd = 1.0f / sqrtf(s * (1.0f / 128.0f) + EPS); const f32x2 g = *(const f32x2*)(p.g_kv + 2 * lane); const f32x2 o = v * rstd * g;
          if (r < NCTX) *(f32x2*)(p.out + OUT_CKV + (size_t)r * 128 + 2 * lane) = o;
          *(unsigned*)(CKVN + kvr * 128 + 2 * lane) = pk2(o[0], o[1]); }
        if (lane < 16) { f32x2 v = *(const f32x2*)(pr + 384 + 2 * lane);
          if (r < NCTX) *(f32x2*)(p.out + OUT_KR + (size_t)r * 32 + 2 * lane) = v;
          else { const int t = (r - NCTX) & 1023; const f32x2 cs = *(const f32x2*)(rope + (size_t)t * 32 + 2 * lane); v = (f32x2){v[0] * cs[0] - v[1] * cs[1], v[0] * cs[1] + v[1] * cs[0]}; }
          *(unsigned*)(KR + kvr * 32 + 2 * lane) = pk2(v[0], v[1]); }
        { const u32x4 w = *(const u32x4*)(UV + (size_t)r * 1024 + 512 + 8 * lane);
          float x[8] = {bflo(w.x), bfhi(w.x), bflo(w.y), bfhi(w.y), bflo(w.z), bfhi(w.z), bflo(w.w), bfhi(w.w)};
          float s = 0.f;
#pragma unroll
          for (int e = 0; e < 8; ++e) s += x[e];
          const float mean = wave_sum(s) * (1.0f / 512.0f); float q = 0.f;
#pragma unroll
          for (int e = 0; e < 8; ++e) { const float d = x[e] - mean; q += d * d; }
          const float rstd = 1.0f / sqrtf(wave_sum(q) * (1.0f / 512.0f) + EPS);
          if (lane == 0) *(f32x2*)(VSTAT + 2 * (size_t)r) = (f32x2){mean, rstd}; }
    }
}

__device__ __forceinline__ void sgu_unit(const Params& p, LAS unsigned char* lds, int chunk, int g) {
    int tid0_ = threadIdx.x; asm volatile("" : "+v"(tid0_)); const int tid = tid0_, lane = tid & 63, wave = tid >> 6, fr = lane & 15, g4 = lane >> 4;
    unsigned char* ws = p.ws;
    const bf16_t* UV = (const bf16_t*)(ws + WS_UV); const float* VSTAT = (const float*)(ws + WS_VSTAT); const bf16_t* WS = (const bf16_t*)(ws + WS_WSGU);
    bf16_t* MIX = (bf16_t*)(ws + WS_MIX);
    const int r0 = chunk * 128;
    LAS bf16_t* vnT = (LAS bf16_t*)lds;
    { const int row = tid >> 2, cc = (tid & 3) * 16;
      const bf16_t* src = UV + (size_t)(r0 + row) * 1024 + 512 + g * 64 + cc;
      const u32x4 w0 = *(const u32x4*)src, w1 = *(const u32x4*)(src + 8);
      const f32x2 st = *(const f32x2*)(VSTAT + 2 * (size_t)(r0 + row));
      const float x[16] = {bflo(w0.x), bfhi(w0.x), bflo(w0.y), bfhi(w0.y), bflo(w0.z), bfhi(w0.z), bflo(w0.w), bfhi(w0.w), bflo(w1.x), bfhi(w1.x), bflo(w1.y), bfhi(w1.y), bflo(w1.z), bfhi(w1.z), bflo(w1.w), bfhi(w1.w)};
#pragma unroll
      for (int e = 0; e < 16; e += 2) { const int c = cc + e;
          const f32x2 gg = *(const f32x2*)(p.g_sgu + g * 64 + c), bb = *(const f32x2*)(p.beta_sgu + g * 64 + c);
          const unsigned w = pk2((x[e] - st[0]) * st[1] * gg[0] + bb[0], (x[e + 1] - st[0]) * st[1] * gg[1] + bb[1]);
          vnT[c * 136 + row] = (bf16_t)(w & 0xffffu); vnT[(c + 1) * 136 + row] = (bf16_t)(w >> 16); } }
    __syncthreads();
    bf16x8 bfr[4];
    { const bf16_t* wp = WS + (size_t)g * 16384 + (size_t)(16 * wave + fr) * 128 + 8 * g4;
#pragma unroll
      for (int ks = 0; ks < 4; ++ks) bfr[ks] = *(const bf16x8*)(wp + 32 * ks); }
    const int token = r0 + 16 * wave + fr; const float bias = p.b_sgu[g * 128 + 16 * wave + fr];
#pragma unroll
    for (int j = 0; j < 4; ++j) { f32x4 acc = {0.f, 0.f, 0.f, 0.f};
#pragma unroll
        for (int ks = 0; ks < 4; ++ks) { const bf16x8 a = *(const LAS bf16x8*)(vnT + (16 * j + fr) * 136 + 32 * ks + 8 * g4); acc = __builtin_amdgcn_mfma_f32_16x16x32_bf16(a, bfr[ks], acc, 0, 0, 0); }
        const int c = 16 * j + 4 * g4; const u32x2 uw = *(const u32x2*)(UV + (size_t)token * 1024 + g * 64 + c);
        u32x2 o; o.x = pk2((acc[0] + bias) * bflo(uw.x), (acc[1] + bias) * bfhi(uw.x)); o.y = pk2((acc[2] + bias) * bflo(uw.y), (acc[3] + bias) * bfhi(uw.y));
        *(u32x2*)(MIX + (size_t)token * 1024 + 512 + g * 64 + c) = o; }
    __syncthreads();
}

__device__ __forceinline__ void attn_unit(const Params& p, LAS unsigned char* lds, int q0, int kv0, int NK, int h) {
    int tid0_ = threadIdx.x; asm volatile("" : "+v"(tid0_)); const int tid = tid0_, lane = tid & 63, wave = tid >> 6, fr = lane & 15, g4 = lane >> 4;
    unsigned char* ws = p.ws;
    const bf16_t* Q = (const bf16_t*)(ws + WS_Q); const bf16_t* KN = (const bf16_t*)(ws + WS_KN); const bf16_t* KR = (const bf16_t*)(ws + WS_KR); const bf16_t* VT = (const bf16_t*)(ws + WS_VT);
    bf16_t* MIX = (bf16_t*)(ws + WS_MIX);
    constexpr int KS = 208, VS = 144, VOFF = 64 * KS, BUFB = 64 * KS + 64 * VS;
    bf16x8 qf[3];
    { const bf16_t* qp = Q + (size_t)(q0 + wave * 16 + fr) * 768 + h * 96 + g4 * 8;
#pragma unroll
      for (int kd = 0; kd < 3; ++kd) qf[kd] = *(const bf16x8*)(qp + kd * 32); }
    f32x4 o[4];
#pragma unroll
    for (int dj = 0; dj < 4; ++dj) o[dj] = (f32x4){0.f, 0.f, 0.f, 0.f};
    float m = -1e30f, l = 0.f;
    const int NT = NK / 64;
    const int krow = tid >> 3, kch = tid & 7, rrow = tid >> 2, rch = tid & 3;
    const bf16_t* kn_src = KN + (size_t)(kv0 + krow) * 512 + h * 64 + kch * 8;
    const bf16_t* kr_src = KR + (size_t)(kv0 + (rrow & 63)) * 32 + rch * 8;
    const bf16_t* vt_src = VT + (size_t)(h * 64 + krow) * NKV + kv0 + kch * 8;
    u32x4 rk, rr, rv;
    rk = *(const u32x4*)kn_src; rv = *(const u32x4*)vt_src; if (tid < 256) rr = *(const u32x4*)kr_src;
    *(LAS u32x4*)(lds + krow * KS + kch * 16) = rk; *(LAS u32x4*)(lds + VOFF + krow * VS + kch * 16) = rv; if (tid < 256) *(LAS u32x4*)(lds + rrow * KS + 128 + rch * 16) = rr;
    __syncthreads();
    for (int t = 0; t < NT; ++t) {
        LAS unsigned char* buf = lds + (t & 1) * BUFB;
        if (t + 1 < NT) { rk = *(const u32x4*)(kn_src + (size_t)(t + 1) * 64 * 512); rv = *(const u32x4*)(vt_src + (t + 1) * 64); if (tid < 256) rr = *(const u32x4*)(kr_src + (size_t)(t + 1) * 64 * 32); }
        f32x4 s[4];
#pragma unroll
        for (int a = 0; a < 4; ++a) { s[a] = (f32x4){0.f, 0.f, 0.f, 0.f};
#pragma unroll
            for (int kd = 0; kd < 3; ++kd) { const bf16x8 kf = *(const LAS bf16x8*)(buf + (16 * a + fr) * KS + kd * 64 + g4 * 16); s[a] = __builtin_amdgcn_mfma_f32_16x16x32_bf16(kf, qf[kd], s[a], 0, 0, 0); } }
        float mx = fmaxf(fmaxf(s[0][0], s[0][1]), fmaxf(s[0][2], s[0][3]));
#pragma unroll
        for (int a = 1; a < 4; ++a) mx = fmaxf(mx, fmaxf(fmaxf(s[a][0], s[a][1]), fmaxf(s[a][2], s[a][3])));
        mx = fmaxf(mx, __shfl_xor(mx, 16)); mx = fmaxf(mx, __shfl_xor(mx, 32));
        const float mn = fmaxf(m, mx); const float alpha = __builtin_amdgcn_exp2f(m - mn); m = mn;
        l *= alpha;
#pragma unroll
        for (int dj = 0; dj < 4; ++dj) o[dj] = o[dj] * alpha;
        float ps = 0.f;
#pragma unroll
        for (int a = 0; a < 4; ++a)
#pragma unroll
            for (int e = 0; e < 4; ++e) { s[a][e] = __builtin_amdgcn_exp2f(s[a][e] - mn); ps += s[a][e]; }
        l += ps;
#pragma unroll
        for (int ks = 0; ks < 2; ++ks) {
            u32x4 pw; pw.x = pk2(s[2 * ks][0], s[2 * ks][1]); pw.y = pk2(s[2 * ks][2], s[2 * ks][3]); pw.z = pk2(s[2 * ks + 1][0], s[2 * ks + 1][1]); pw.w = pk2(s[2 * ks + 1][2], s[2 * ks + 1][3]);
            const bf16x8 pf = __builtin_bit_cast(bf16x8, pw);
#pragma unroll
            for (int dj = 0; dj < 4; ++dj) { const LAS unsigned char* vp = buf + VOFF + (16 * dj + fr) * VS + (32 * ks + 4 * g4) * 2;
                const u32x2 lo = *(const LAS u32x2*)vp, hi = *(const LAS u32x2*)(vp + 32);
                u32x4 vw; vw.x = lo.x; vw.y = lo.y; vw.z = hi.x; vw.w = hi.y;
                o[dj] = __builtin_amdgcn_mfma_f32_16x16x32_bf16(__builtin_bit_cast(bf16x8, vw), pf, o[dj], 0, 0, 0); }
        }
        if (t + 1 < NT) { LAS unsigned char* nb = lds + ((t + 1) & 1) * BUFB;
            *(LAS u32x4*)(nb + krow * KS + kch * 16) = rk; *(LAS u32x4*)(nb + VOFF + krow * VS + kch * 16) = rv; if (tid < 256) *(LAS u32x4*)(nb + rrow * KS + 128 + rch * 16) = rr; }
        __syncthreads();
    }
    l += __shfl_xor(l, 16); l += __shfl_xor(l, 32);
    const float inv = 1.0f / l;
    bf16_t* op = MIX + (size_t)(q0 + wave * 16 + fr) * 1024 + h * 64 + 4 * g4;
#pragma unroll
    for (int dj = 0; dj < 4; ++dj) { u32x2 w; w.x = pk2(o[dj][0] * inv, o[dj][1] * inv); w.y = pk2(o[dj][2] * inv, o[dj][3] * inv); *(u32x2*)(op + 16 * dj) = w; }
}
__device__ __forceinline__ void phase_attn(const Params& p, LAS unsigned char* lds) {
    for (int u = blockIdx.x; u < 768; u += gridDim.x) {
        if (u < 256) { const int b = u >> 6, h = (u >> 3) & 7, qb = u & 7; attn_unit(p, lds, NCTX + b * 1024 + qb * 128, NCTX + b * 1280, 1280, h); }
        else { const int v = u - 256, b = v >> 4, h = (v >> 1) & 7, qb = v & 1; attn_unit(p, lds, b * 256 + qb * 128, b * 256, 256, h); }
    }
}

__device__ __forceinline__ void phase_post1(const Params& p) {
    int tid0_ = threadIdx.x; asm volatile("" : "+v"(tid0_)); const int tid = tid0_, lane = tid & 63, wave = tid >> 6;
    const int gw = blockIdx.x * 8 + wave, NGW = gridDim.x * 8;
    const float* MOD = (const float*)(p.ws + WS_MOD); const bf16_t* MIXO = (const bf16_t*)(p.ws + WS_MIXO); bf16_t* H = (bf16_t*)(p.ws + WS_H);
    for (int r = gw; r < MTOK; r += NGW) {
        const float* xr = xrow(p, r); const float* md = MOD + cls_of(r) * 6144; float* yr = p.out + OUT_Y + (size_t)r * D;
        float mv[16]; float s = 0.f;
#pragma unroll
        for (int j = 0; j < 2; ++j) { const u32x4 w = *(const u32x4*)(MIXO + (size_t)r * D + 8 * lane + 512 * j);
            mv[8 * j + 0] = bflo(w.x); mv[8 * j + 1] = bfhi(w.x); mv[8 * j + 2] = bflo(w.y); mv[8 * j + 3] = bfhi(w.y); mv[8 * j + 4] = bflo(w.z); mv[8 * j + 5] = bfhi(w.z); mv[8 * j + 6] = bflo(w.w); mv[8 * j + 7] = bfhi(w.w); }
#pragma unroll
        for (int e = 0; e < 16; ++e) s += mv[e] * mv[e];
        const float rs = 1.0f / sqrtf(wave_sum(s) * (1.0f / D) + EPS);
        float x1[16]; float s1 = 0.f;
#pragma unroll
        for (int j = 0; j < 2; ++j)
#pragma unroll
            for (int q = 0; q < 2; ++q) { const int col = 8 * lane + 512 * j + 4 * q;
                const f32x4 xv = *(const f32x4*)(xr + col), ga = *(const f32x4*)(md + 2048 + col), gp = *(const f32x4*)(p.g_attn_post + col);
#pragma unroll
                for (int e = 0; e < 4; ++e) { const float v = xv[e] + ga[e] * (mv[8 * j + 4 * q + e] * rs * gp[e]); x1[8 * j + 4 * q + e] = v; s1 += v * v; }
                *(f32x4*)(yr + col) = (f32x4){x1[8 * j + 4 * q], x1[8 * j + 4 * q + 1], x1[8 * j + 4 * q + 2], x1[8 * j + 4 * q + 3]}; }
        const float r1 = 1.0f / sqrtf(wave_sum(s1) * (1.0f / D) + EPS);
#pragma unroll
        for (int j = 0; j < 2; ++j) { const int col = 8 * lane + 512 * j; float hv[8];
#pragma unroll
            for (int q = 0; q < 2; ++q) { const f32x4 g = *(const f32x4*)(p.g_ffn_pre + col + 4 * q), sh = *(const f32x4*)(md + 3072 + col + 4 * q), sc = *(const f32x4*)(md + 4096 + col + 4 * q);
#pragma unroll
                for (int e = 0; e < 4; ++e) hv[4 * q + e] = x1[8 * j + 4 * q + e] * r1 * g[e] * (1.0f + sc[e]) + sh[e]; }
            u32x4 w; w.x = pk2(hv[0], hv[1]); w.y = pk2(hv[2], hv[3]); w.z = pk2(hv[4], hv[5]); w.w = pk2(hv[6], hv[7]);
            *(u32x4*)(H + (size_t)r * D + col) = w; }
    }
}
__device__ __forceinline__ void phase_final(const Params& p) {
    int tid0_ = threadIdx.x; asm volatile("" : "+v"(tid0_)); const int tid = tid0_, lane = tid & 63, wave = tid >> 6;
    const int gw = blockIdx.x * 8 + wave, NGW = gridDim.x * 8;
    const float* MOD = (const float*)(p.ws + WS_MOD); const bf16_t* F = (const bf16_t*)(p.ws + WS_F);
    for (int r = gw; r < MTOK; r += NGW) {
        const float* md = MOD + cls_of(r) * 6144; float* yr = p.out + OUT_Y + (size_t)r * D;
        float fv[16]; float s = 0.f;
#pragma unroll
        for (int j = 0; j < 2; ++j) { const u32x4 w = *(const u32x4*)(F + (size_t)r * D + 8 * lane + 512 * j);
            fv[8 * j + 0] = bflo(w.x); fv[8 * j + 1] = bfhi(w.x); fv[8 * j + 2] = bflo(w.y); fv[8 * j + 3] = bfhi(w.y); fv[8 * j + 4] = bflo(w.z); fv[8 * j + 5] = bfhi(w.z); fv[8 * j + 6] = bflo(w.w); fv[8 * j + 7] = bfhi(w.w); }
#pragma unroll
        for (int e = 0; e < 16; ++e) s += fv[e] * fv[e];
        const float rs = 1.0f / sqrtf(wave_sum(s) * (1.0f / D) + EPS);
#pragma unroll
        for (int j = 0; j < 2; ++j)
#pragma unroll
            for (int q = 0; q < 2; ++q) { const int col = 8 * lane + 512 * j + 4 * q;
                const f32x4 xv = *(const f32x4*)(yr + col), gf = *(const f32x4*)(md + 5120 + col), gp = *(const f32x4*)(p.g_ffn_post + col);
                f32x4 y;
#pragma unroll
                for (int e = 0; e < 4; ++e) y[e] = xv[e] + gf[e] * (fv[8 * j + 4 * q + e] * rs * gp[e]);
                *(f32x4*)(yr + col) = y; }
    }
}

#define XB_TMO      128
#define XB_XCNT(j)  (256  + 64 * (j))
#define XB_XSUB(j)  (1280 + 64 * (j))
#define XB_XGEN(j)  (2304 + 64 * (j))
#define XB_TOP      3328
#define XB_TOPGEN   3392
#define XCD_BAR_WORDS 3456
#define XB_SPIN_CAP (1u << 18)

__device__ __forceinline__ unsigned xb_ld(unsigned* p)              { return __hip_atomic_load(p, __ATOMIC_RELAXED, __HIP_MEMORY_SCOPE_AGENT); }
__device__ __forceinline__ unsigned xb_add(unsigned* p, unsigned v) { return __hip_atomic_fetch_add(p, v, __ATOMIC_RELAXED, __HIP_MEMORY_SCOPE_AGENT); }
__device__ __forceinline__ unsigned xb_xcc_id() { return (unsigned)__builtin_amdgcn_s_getreg((3 << 11) | 20) & 0xFu; }
#define XB_SPIN(cond, bar) do { unsigned _sp = 0; while (cond) { __builtin_amdgcn_s_sleep(1); \
    if ((++_sp & 255u) == 0u) { if (xb_ld(&(bar)[XB_TMO])) break; if (_sp > XB_SPIN_CAP) { atomicAdd(&(bar)[XB_TMO], 1u); break; } } } } while (0)

struct XcdBarrier {
    unsigned* bar; unsigned x;
    volatile LAS unsigned* st;
};

__device__ __forceinline__ XcdBarrier xcd_barrier_post(unsigned* bar, volatile LAS unsigned* st) {
    XcdBarrier b; b.bar = bar; b.x = xb_xcc_id(); b.st = st;
    if (threadIdx.x == 0) (void)xb_add(&bar[XB_XCNT(b.x)], 1u);
    return b;
}
__device__ __forceinline__ void xcd_barrier_complete(unsigned* bar, unsigned x, unsigned& nloc, unsigned& nx) {
    const unsigned G = gridDim.x * gridDim.y * gridDim.z;
    unsigned sum, cnt, mine, sp = 0u;
    for (;;) {
        sum = 0u; cnt = 0u; mine = 0u;
#pragma unroll
        for (unsigned j = 0; j < 16; ++j) { const unsigned c = xb_ld(&bar[XB_XCNT(j)]); sum += c; cnt += (c > 0u) ? 1u : 0u; mine = (j == x) ? c : mine; }
        if (sum == G) break;
        __builtin_amdgcn_s_sleep(1);
        if ((++sp & 255u) == 0u) { if (xb_ld(&bar[XB_TMO])) break; if (sp > XB_SPIN_CAP) { atomicAdd(&bar[XB_TMO], 1u); break; } }
    }
    nloc = mine > 0u ? mine : 1u; nx = cnt > 0u ? cnt : 1u;
}

__device__ __forceinline__ void xcd_barrier(const XcdBarrier& b) {
    asm volatile("s_waitcnt vmcnt(0)" ::: "memory");
    __syncthreads();
    if (threadIdx.x == 0) {
        unsigned* bar = b.bar;
        __builtin_amdgcn_s_waitcnt(0);
        unsigned nloc = b.st[0], nx = b.st[1];
        if (nloc == 0u) { xcd_barrier_complete(bar, b.x, nloc, nx); b.st[0] = nloc; b.st[1] = nx; }
        const unsigned old = xb_add(&bar[XB_XSUB(b.x)], 1u);
        const unsigned gen = old / nloc;
        if (old + 1u == (gen + 1u) * nloc) {
            __builtin_amdgcn_fence(__ATOMIC_RELEASE, "agent");
            asm volatile("s_waitcnt vmcnt(0)" ::: "memory");
            const unsigned og = xb_add(&bar[XB_TOP], 1u);
            const unsigned tg = og / nx;
            if (og + 1u == (tg + 1u) * nx) xb_add(&bar[XB_TOPGEN], 1u);
            else XB_SPIN(xb_ld(&bar[XB_TOPGEN]) == tg, bar);
            __builtin_amdgcn_fence(__ATOMIC_ACQUIRE, "agent");
            xb_add(&bar[XB_XGEN(b.x)], 1u);
            asm volatile("s_waitcnt vmcnt(0)" ::: "memory");
        } else {
            XB_SPIN(xb_ld(&bar[XB_XGEN(b.x)]) == gen, bar);
            __builtin_amdgcn_fence(__ATOMIC_ACQUIRE, "agent");
            asm volatile("s_waitcnt vmcnt(0)" ::: "memory");
        }
    }
    __syncthreads();
}
constexpr int LDS_BYTES = 131072 + 1024;
#define GSYNC() xcd_barrier(bar)
template <class Epi> __device__ __forceinline__ void run_gemm(LAS unsigned char* lds, const bf16_t* A, const bf16_t* Bt, int M, int N, int K, const Epi& E) {
    pg8::Gemm g{A, Bt, M, N, K}; pg8::StaticOrder S; S.init(M, N, (int)gridDim.x, (int)blockIdx.x);
    pg8::gemm_phase<Epi, pg8::StaticOrder, true, true>(lds, g, S, E);
}
__global__ void __launch_bounds__(512, 2) fwd_megakernel(Params p) {
    extern __shared__ __attribute__((aligned(16))) unsigned char smem[];
    LAS unsigned char* lds = (LAS unsigned char*)smem;
    unsigned char* ws = p.ws;
    if (ws == nullptr) { cg::this_grid().sync(); }
    { volatile LAS unsigned* st = (volatile LAS unsigned*)(lds + 131072); if (threadIdx.x < 64) st[threadIdx.x] = 0u; }
    __syncthreads();
    XcdBarrier bar = xcd_barrier_post((unsigned*)(ws + WS_BAR), (volatile LAS unsigned*)(lds + 131072 + 32));
#ifndef PH
#define PH 0xFFFF
#endif
#if PH & 1
    phase0(p, lds);
#endif
    GSYNC();
#if PH & 2
    phase_xn(p);
#endif
    GSYNC();
#if PH & 4
    { EpiInProj E{(float*)(ws + WS_PROJ), (bf16_t*)(ws + WS_UV)}; run_gemm(lds, (const bf16_t*)(ws + WS_H), (const bf16_t*)(ws + WS_WIN), MTOK, NPROJ, 1024, E); }
#endif
    GSYNC();
#if PH & 8
    phase_prep(p);
#endif
    GSYNC();
#if PH & 16
    { EpiQ E{(bf16_t*)(ws + WS_Q), (const float*)(ws + WS_ROPE)}; run_gemm(lds, (const bf16_t*)(ws + WS_CQN), (const bf16_t*)(ws + WS_WUQ), MTOK, 768, 256, E); }
#endif
#if PH & 32
    { EpiStore<0> E{(bf16_t*)(ws + WS_KN), 512}; run_gemm(lds, (const bf16_t*)(ws + WS_CKVN), (const bf16_t*)(ws + WS_WK), NKV, 512, 128, E); }
    { EpiStore<0> E{(bf16_t*)(ws + WS_VT), NKV}; run_gemm(lds, (const bf16_t*)(ws + WS_WV), (const bf16_t*)(ws + WS_CKVN), 512, NKV, 128, E); }
#endif
    __syncthreads();
#if PH & 64
    for (int u = blockIdx.x; u < 768; u += gridDim.x) sgu_unit(p, lds, u >> 3, u & 7);
#endif
    GSYNC();
#if PH & 128
    phase_attn(p, lds);
#endif
    GSYNC();
#if PH & 256
    { EpiStore<0> E{(bf16_t*)(ws + WS_MIXO), 1024}; run_gemm(lds, (const bf16_t*)(ws + WS_MIX), (const bf16_t*)(ws + WS_WO), MTOK, 1024, 1024, E); }
#endif
    GSYNC();
#if PH & 512
    phase_post1(p);
#endif
    GSYNC();
#if PH & 1024
    { EpiStore<1> E{(bf16_t*)(ws + WS_A1), DFF}; run_gemm(lds, (const bf16_t*)(ws + WS_H), (const bf16_t*)(ws + WS_W1), MTOK, DFF, 1024, E); }
#endif
    GSYNC();
#if PH & 2048
    { EpiStore<0> E{(bf16_t*)(ws + WS_F), 1024}; run_gemm(lds, (const bf16_t*)(ws + WS_A1), (const bf16_t*)(ws + WS_W2), MTOK, 1024, DFF, E); }
#endif
    GSYNC();
#if PH & 4096
    phase_final(p);
#endif
}

extern "C" void kernel_launch(void* const* d_in, const int* in_sizes, int n_in, void* d_out, int out_size, void* d_ws, size_t ws_size, hipStream_t stream) {
    static int grid_blocks = 0;
    if (grid_blocks == 0) {
        if (n_in != 24 || ws_size < WS_END) { fprintf(stderr, "kernel_launch: unexpected n_in %d / ws %zu\n", n_in, ws_size); grid_blocks = -1; return; }
        int dev = 0, cus = 0, per_cu = 0;
        hipGetDevice(&dev); hipDeviceGetAttribute(&cus, hipDeviceAttributeMultiprocessorCount, dev);
        hipFuncSetAttribute((const void*)fwd_megakernel, hipFuncAttributeMaxDynamicSharedMemorySize, LDS_BYTES);
        hipOccupancyMaxActiveBlocksPerMultiprocessor(&per_cu, (const void*)fwd_megakernel, 512, LDS_BYTES);
        if (per_cu < 1) { fprintf(stderr, "kernel_launch: occupancy query says %d\n", per_cu); per_cu = 1; }
        grid_blocks = cus;
        (void)hipGetLastError();
    }
    if (grid_blocks < 0) return;
    Params p{};
    const float** pp = (const float**)&p;
    for (int i = 0; i < 24; ++i) pp[i] = (const float*)d_in[i];
    p.out = (float*)d_out; p.ws = (unsigned char*)d_ws;
    if (hipMemsetAsync((unsigned char*)d_ws + WS_BAR, 0, XCD_BAR_WORDS * 4, stream) != hipSuccess) { fprintf(stderr, "memset failed\n"); return; }
    void* args[] = {&p};
    hipError_t e = hipLaunchCooperativeKernel((void*)fwd_megakernel, dim3(grid_blocks), dim3(512), args, LDS_BYTES, stream);
    if (e != hipSuccess) fprintf(stderr, "cooperative launch failed: %s (grid %d)\n", hipGetErrorString(e), grid_blocks);
}
```

```cpp
#include <hip/hip_runtime.h>
#include <hip/hip_cooperative_groups.h>
#include <cstdio>
#include <cstdint>
namespace cg = cooperative_groups;
namespace pg8 {
#define PG8_LAS __attribute__((address_space(3)))
typedef unsigned short bf16_t;
typedef short bf16x8 __attribute__((ext_vector_type(8)));
typedef float f32x4 __attribute__((ext_vector_type(4)));
typedef unsigned u32x4 __attribute__((ext_vector_type(4)));
constexpr int BM = 256, BK = 64, HALF = 128, HTB = HALF * BK * 2  , STAGE_BYTES = 8 * HTB, NXCD = 8, WGM = 8;

__host__ __device__ __forceinline__ int lds_byte(int r, int c) { const int st = (r >> 4) * 2 + (c >> 5), rr = r & 15, cc = c & 31, ob = rr * 64 + cc * 2; return st * 1024 + (ob ^ (((ob >> 9) & 1) << 5)); }
__host__ __device__ __forceinline__ void stage_rc(int b, int& R, int& C) { const int st = b / 1024, sb = b % 1024, swz = sb ^ (((sb >> 9) & 1) << 5); R = (st >> 1) * 16 + swz / 64; C = (st & 1) * 32 + (swz % 64) / 2; }
__host__ __device__ __forceinline__ int perm32(int rho) { const int n = rho >> 4, i = rho & 15; return 8 * (i >> 2) + 4 * n + (i & 3); }

struct Unit { int pm, pn; };
struct Gemm { const bf16_t* A; const bf16_t* Bt; int M, N, K; };

struct StaticOrder {
    int nM, nN, nwg, G, c;
    __host__ __device__ void init(int M, int N, int G_, int c_, int bm = BM) { nM = M / bm; nN = N / BM; nwg = nM * nN; G = G_; c = c_; }
    __host__ __device__ bool next(int i, Unit& u) const {
        const long L = (long)i * G + c; if (L >= nwg) return false;
        int wgid = (int)L; { const int q = nwg / NXCD, r = nwg % NXCD, xcd = wgid % NXCD, off = wgid / NXCD; wgid = (xcd < r ? xcd * (q + 1) : r * (q + 1) + (xcd - r) * q) + off; }
        const int nig = WGM * nN, gid = wgid / nig, fm = gid * WGM, gsz = (nM - fm) < WGM ? (nM - fm) : WGM;
        u.pm = fm + ((wgid % nig) % gsz); u.pn = (wgid % nig) / gsz; return true;
    }
    __device__ __forceinline__ void a_ready(const Unit&) const {}
    __device__ __forceinline__ void done(const Unit&) const {}
};

__device__ __forceinline__ unsigned cvt_pk_bf16(float lo, float hi) { unsigned r; asm volatile("v_cvt_pk_bf16_f32 %0, %1, %2" : "=v"(r) : "v"(lo), "v"(hi)); return r; }
typedef float f32x2 __attribute__((ext_vector_type(2)));
template <class Epi, class Sched, bool ALIGN_EPI = false, bool SP2 = false, int MT = 4>
__device__ __forceinline__ void gemm_phase(PG8_LAS unsigned char* lds, const Gemm g, const Sched& S, const Epi& E) {
    int tid0_ = threadIdx.x; asm volatile("" : "+v"(tid0_)); const int tid = tid0_, wid = __builtin_amdgcn_readfirstlane(tid >> 6), lane = tid & 63, wr = wid >> 2, wc = wid & 3, fr = lane & 15, fq = lane >> 4;
    const int K = g.K, nt = K / BK;
    unsigned voffA[2], voffB[2];
#pragma unroll
    for (int i = 0; i < 2; ++i) { int R, C; stage_rc(tid * 16 + i * 8192, R, C); const int Rb = Epi::PERM ? ((R & ~31) + perm32(R & 31)) : R;
        voffA[i] = (unsigned)(R * K + C) * 2u; voffB[i] = (unsigned)(Rb * K + C) * 2u; }
    const size_t kstep = (size_t)(BK * 2);
    const size_t hstep = (size_t)HALF * K * 2, hstepA = (size_t)(32 * MT) * K * 2;
    const size_t tstep = 2 * hstep, tstepA = 2 * hstepA;
    const unsigned ldsw = (unsigned)wid * 1024u;
    const int aoff = lds_byte(wr * (16 * MT) + fr, fq * 8), boff = lds_byte(wc * 32 + fr, fq * 8);
#define PG8_SA(b, h) (((b) * 2 + (h)) * HTB)
#define PG8_SB(b, h) ((4 + (b) * 2 + (h)) * HTB)
#define PG8_STAGE(bufoff, gbase, voff) do { _Pragma("unroll") for (int _i = 0; _i < 2; ++_i) \
        __builtin_amdgcn_global_load_lds((const unsigned*)((const char*)(gbase) + (voff)[_i]), (PG8_LAS unsigned*)(lds + (bufoff) + ldsw + _i * 8192), 16, 0, 0); } while (0)
#define PG8_LDA(dst, b, h) do { _Pragma("unroll") for (int m = 0; m < MT; ++m) _Pragma("unroll") for (int k = 0; k < 2; ++k) dst[m][k] = *(const PG8_LAS bf16x8*)(lds + PG8_SA(b, h) + aoff + m * 2048 + k * 1024); } while (0)
#define PG8_LDB(dst, b, h) do { _Pragma("unroll") for (int n = 0; n < 2; ++n) _Pragma("unroll") for (int k = 0; k < 2; ++k) dst[n][k] = *(const PG8_LAS bf16x8*)(lds + PG8_SB(b, h) + boff + n * 2048 + k * 1024); } while (0)
#define PG8_MMA(ai, bj, At, Bt) do { __builtin_amdgcn_s_setprio(1); _Pragma("unroll") for (int m = 0; m < MT; ++m) _Pragma("unroll") for (int n = 0; n < 2; ++n) _Pragma("unroll") for (int k = 0; k < 2; ++k) \
        acc[ai][bj][m][n] = __builtin_amdgcn_mfma_f32_16x16x32_bf16(Bt[n][k], At[m][k], acc[ai][bj][m][n], 0, 0, 0); __builtin_amdgcn_s_setprio(0); } while (0)
#define PG8_WAIT_V(n) asm volatile("s_waitcnt vmcnt(" #n ")" ::: "memory")
#define PG8_WAIT_L(n) asm volatile("s_waitcnt lgkmcnt(" #n ")" ::: "memory")
#define PG8_BAR __builtin_amdgcn_s_barrier()
#define PG8_SCHED __builtin_amdgcn_sched_barrier(0)
    Unit cur, nxt; int ui = 0;
    if (!S.next(0, cur)) return;
    f32x4 acc[2][2][MT][2];
#pragma unroll
    for (int a = 0; a < 2; ++a)
#pragma unroll
        for (int b = 0; b < 2; ++b)
#pragma unroll
            for (int m = 0; m < MT; ++m)
#pragma unroll
                for (int n = 0; n < 2; ++n) acc[a][b][m][n] = (f32x4){0.f, 0.f, 0.f, 0.f};
    bf16x8 At[MT][2], B0[2][2], B1[2][2];
    const char* cA = (const char*)g.A + (size_t)cur.pm * tstepA; const char* cB = (const char*)g.Bt + (size_t)cur.pn * tstep;
    S.a_ready(cur);
    if constexpr (SP2) {
        PG8_STAGE(PG8_SB(0, 0), cB, voffB); PG8_STAGE(PG8_SB(0, 1), cB + hstep, voffB); PG8_STAGE(PG8_SA(0, 0), cA, voffA); PG8_STAGE(PG8_SA(0, 1), cA + hstepA, voffA);
        if (wr == 1) PG8_BAR;
        PG8_WAIT_V(2); PG8_BAR;
        PG8_STAGE(PG8_SB(1, 0), cB + kstep, voffB); PG8_STAGE(PG8_SA(1, 0), cA + kstep, voffA); PG8_STAGE(PG8_SB(1, 1), cB + hstep + kstep, voffB);
        PG8_WAIT_V(6); PG8_BAR;
    } else {
        PG8_STAGE(PG8_SB(0, 0), cB, voffB); PG8_STAGE(PG8_SA(0, 0), cA, voffA); PG8_STAGE(PG8_SB(0, 1), cB + hstep, voffB); PG8_STAGE(PG8_SA(0, 1), cA + hstepA, voffA);
        if (wr == 1) PG8_BAR;
        PG8_WAIT_V(4); PG8_BAR;
        PG8_STAGE(PG8_SB(1, 0), cB + kstep, voffB); PG8_STAGE(PG8_SA(1, 0), cA + kstep, voffA); PG8_STAGE(PG8_SB(1, 1), cB + hstep + kstep, voffB);
        PG8_WAIT_V(6); PG8_BAR;
    }
    for (;;) {
        const bool has_next = S.next(ui + 1, nxt);
        const char* nA = has_next ? (const char*)g.A + (size_t)nxt.pm * tstepA : cA; const char* nB = has_next ? (const char*)g.Bt + (size_t)nxt.pn * tstep : cB;
        for (int t = 0; t < nt; t += 2) {
            const bool last = (t == nt - 2);
            const char* a1 = cA + (size_t)(t + 1) * kstep;
            const char* a2 = last ? nA : cA + (size_t)(t + 2) * kstep; const char* b2 = last ? nB : cB + (size_t)(t + 2) * kstep;
            const char* a3 = a2 + kstep; const char* b3 = b2 + kstep;
            if (last && has_next) S.a_ready(nxt);
            if constexpr (SP2) {
            PG8_LDB(B0, 0, 0); PG8_LDB(B1, 0, 1); PG8_SCHED; PG8_LDA(At, 0, 0); PG8_STAGE(PG8_SA(1, 1), a1 + hstepA, voffA);
            PG8_WAIT_V(8); PG8_WAIT_L(0); PG8_BAR; PG8_MMA(0, 0, At, B0); PG8_MMA(0, 1, At, B1); PG8_BAR; PG8_SCHED;
            PG8_LDA(At, 0, 1); PG8_STAGE(PG8_SB(0, 0), b2, voffB); PG8_STAGE(PG8_SB(0, 1), b2 + hstep, voffB); PG8_STAGE(PG8_SA(0, 0), a2, voffA);
            PG8_WAIT_V(8); PG8_WAIT_L(0); PG8_BAR; PG8_MMA(1, 0, At, B0); PG8_MMA(1, 1, At, B1); PG8_BAR; PG8_SCHED;
            PG8_LDB(B0, 1, 0); PG8_LDB(B1, 1, 1); PG8_SCHED; PG8_LDA(At, 1, 0); PG8_STAGE(PG8_SA(0, 1), a2 + hstepA, voffA);
            PG8_WAIT_V(8); PG8_WAIT_L(0); PG8_BAR; PG8_MMA(0, 0, At, B0); PG8_MMA(0, 1, At, B1); PG8_BAR; PG8_SCHED;
            PG8_LDA(At, 1, 1); PG8_STAGE(PG8_SB(1, 0), b3, voffB); PG8_STAGE(PG8_SB(1, 1), b3 + hstep, voffB); PG8_STAGE(PG8_SA(1, 0), a3, voffA);
            PG8_WAIT_V(8); PG8_WAIT_L(0); PG8_BAR; PG8_MMA(1, 0, At, B0); PG8_MMA(1, 1, At, B1); PG8_BAR; PG8_SCHED;
            } else {
            PG8_LDB(B0, 0, 0); PG8_SCHED; PG8_LDA(At, 0, 0); PG8_STAGE(PG8_SA(1, 1), a1 + hstepA, voffA);
            PG8_WAIT_L(8); PG8_BAR; PG8_WAIT_L(0); PG8_MMA(0, 0, At, B0); PG8_BAR; PG8_SCHED;
            PG8_LDB(B1, 0, 1); PG8_STAGE(PG8_SB(0, 0), b2, voffB);
            PG8_BAR; PG8_WAIT_L(0); PG8_MMA(0, 1, At, B1); PG8_BAR;
            PG8_LDA(At, 0, 1); PG8_STAGE(PG8_SA(0, 0), a2, voffA);
            PG8_BAR; PG8_WAIT_L(0); PG8_MMA(1, 0, At, B0); PG8_BAR; PG8_SCHED;
            PG8_STAGE(PG8_SB(0, 1), b2 + hstep, voffB);
            PG8_WAIT_V(6); PG8_BAR; PG8_MMA(1, 1, At, B1); PG8_BAR;
            PG8_LDB(B0, 1, 0); PG8_SCHED; PG8_LDA(At, 1, 0); PG8_STAGE(PG8_SA(0, 1), a2 + hstepA, voffA);
            PG8_WAIT_L(8); PG8_BAR; PG8_WAIT_L(0); PG8_MMA(0, 0, At, B0); PG8_BAR; PG8_SCHED;
            PG8_LDB(B1, 1, 1); PG8_STAGE(PG8_SB(1, 0), b3, voffB);
            PG8_BAR; PG8_WAIT_L(0); PG8_MMA(0, 1, At, B1); PG8_BAR;
            PG8_LDA(At, 1, 1); PG8_STAGE(PG8_SA(1, 0), a3, voffA);
            PG8_BAR; PG8_WAIT_L(0); PG8_MMA(1, 0, At, B0); PG8_BAR; PG8_SCHED;
            PG8_STAGE(PG8_SB(1, 1), b3 + hstep, voffB);
            PG8_WAIT_V(6); PG8_BAR; PG8_MMA(1, 1, At, B1); PG8_BAR;
            }
        }
        if constexpr (ALIGN_EPI) { if (wr == 0) PG8_BAR; }
        if constexpr (!Epi::AFTER_DRAIN) { E(acc, cur, wr, wc, fr, fq); S.done(cur); }
        if (!has_next) break;
#pragma unroll
        for (int a = 0; a < 2; ++a)
#pragma unroll
            for (int b = 0; b < 2; ++b)
#pragma unroll
                for (int m = 0; m < MT; ++m)
#pragma unroll
                    for (int n = 0; n < 2; ++n) acc[a][b][m][n] = (f32x4){0.f, 0.f, 0.f, 0.f};
        cur = nxt; cA = nA; cB = nB; ++ui;
        if constexpr (ALIGN_EPI) { if (wr == 1) PG8_BAR; }
    }
    PG8_WAIT_V(0);
    if constexpr (!ALIGN_EPI) { if (wr == 0) PG8_BAR; }
    PG8_BAR;
    if constexpr (Epi::AFTER_DRAIN) { E.fused(acc, cur, wr, wc, fr, fq, lds, wid, lane); S.done(cur); }
#undef PG8_SA
#undef PG8_SB
#undef PG8_STAGE
#undef PG8_LDA
#undef PG8_LDB
#undef PG8_MMA
#undef PG8_WAIT_V
#undef PG8_WAIT_L
#undef PG8_BAR
#undef PG8_SCHED
}
}
#define LAS __attribute__((address_space(3)))
typedef unsigned short bf16_t;
typedef short bf16x8 __attribute__((ext_vector_type(8)));
typedef float f32x4 __attribute__((ext_vector_type(4)));
typedef float f32x2 __attribute__((ext_vector_type(2)));
typedef unsigned u32x4 __attribute__((ext_vector_type(4)));
typedef unsigned u32x2 __attribute__((ext_vector_type(2)));
using pg8::cvt_pk_bf16;

constexpr int D = 1024, NCTX = 8192, NLAT = 4096, MTOK = 12288, NKV = 13312;
constexpr int NPROJ = 1536;
constexpr int DFF = 4096;
constexpr float EPS = 1e-6f;
constexpr float QSCALE = 0.10206207261596575f * 1.4426950408889634f;

constexpr size_t MiB = 1u << 20;
constexpr size_t WS_BAR = 176 * MiB;
constexpr size_t WS_MOD = 0;
constexpr size_t WS_ROPE = 128 * 1024;
constexpr size_t WS_VSTAT = 256 * 1024;
constexpr size_t WS_WUQ = 512 * 1024;
constexpr size_t WS_WK = 896 * 1024;
constexpr size_t WS_WV = 1024 * 1024;
constexpr size_t WS_WSGU = 1152 * 1024;
constexpr size_t WS_WIN = 2 * MiB;
constexpr size_t WS_WO = 5 * MiB;
constexpr size_t WS_W1 = 7 * MiB;
constexpr size_t WS_W2 = 15 * MiB;
constexpr size_t WS_H = 24 * MiB;
constexpr size_t WS_UV = 48 * MiB;
constexpr size_t WS_F = WS_UV;
constexpr size_t WS_PROJ = 72 * MiB;
constexpr size_t WS_MIXO = WS_PROJ;
constexpr size_t WS_CQN = 96 * MiB;
constexpr size_t WS_CKVN = 102 * MiB;
constexpr size_t WS_KR = 106 * MiB;
constexpr size_t WS_Q = 107 * MiB;
constexpr size_t WS_KN = 125 * MiB;
constexpr size_t WS_VT = 138 * MiB;
constexpr size_t WS_MIX = 151 * MiB;
constexpr size_t WS_A1 = 72 * MiB;
constexpr size_t WS_END = 177 * MiB;

constexpr size_t OUT_Y = 0, OUT_CKV = (size_t)MTOK * D, OUT_KR = OUT_CKV + (size_t)NCTX * 128;

struct Params {
    const float *x_prompt, *x_sample, *cache_ckv, *cache_krope, *c, *c_ctx, *w_mod, *b_mod, *g_attn_pre, *g_attn_post, *w_in, *g_q, *w_uq, *g_kv, *w_ukv,
        *w_sgu, *b_sgu, *g_sgu, *beta_sgu, *w_o, *g_ffn_pre, *g_ffn_post, *w_ff1, *w_ff2;
    float* out; unsigned char* ws;
};

__device__ __forceinline__ float bf2f(unsigned short b) { return __uint_as_float((unsigned)b << 16); }
__device__ __forceinline__ float bflo(unsigned w) { return __uint_as_float(w << 16); }
__device__ __forceinline__ float bfhi(unsigned w) { return __uint_as_float(w & 0xffff0000u); }
__device__ __forceinline__ float wave_sum(float v) {
#pragma unroll
    for (int o = 1; o < 64; o <<= 1) v += __shfl_xor(v, o);
    return v;
}
__device__ __forceinline__ const float* xrow(const Params& p, int r) { return r < NCTX ? p.x_prompt + (size_t)r * D : p.x_sample + (size_t)(r - NCTX) * D; }
__device__ __forceinline__ int cls_of(int r) { return r < NCTX ? 0 : 1 + ((r - NCTX) >> 10); }
__device__ __forceinline__ int kvrow_of(int r) { return r < NCTX ? r : NCTX + ((r - NCTX) >> 10) * 1280 + 256 + ((r - NCTX) & 1023); }
__device__ __forceinline__ float gelu_tanh(float x) {
    const float u = 0.7978845608028654f * (x + 0.044715f * x * x * x);
    return x / (1.0f + __builtin_amdgcn_exp2f(-2.0f * 1.4426950408889634f * u));
}

template <int ACT  , int MT = 4> struct EpiStore {
    static constexpr bool PERM = true, AFTER_DRAIN = false;
    bf16_t* O; int ldc;
    __device__ __forceinline__ void operator()(const f32x4 (&acc)[2][2][MT][2], const pg8::Unit& u, int wr, int wc, int fr, int fq) const {
        const int row0 = u.pm * (64 * MT) + wr * (16 * MT) + fr, col0 = u.pn * 256 + wc * 32 + 8 * fq;
#pragma unroll
        for (int ai = 0; ai < 2; ++ai)
#pragma unroll
            for (int m = 0; m < MT; ++m) { bf16_t* rowp = O + (size_t)(row0 + ai * (32 * MT) + m * 16) * ldc + col0;
#pragma unroll
                for (int bj = 0; bj < 2; ++bj) { f32x4 v0 = acc[ai][bj][m][0], v1 = acc[ai][bj][m][1];
                    if (ACT == 1) {
#pragma unroll
                        for (int e = 0; e < 4; ++e) { float a = fmaxf(v0[e], 0.f), b = fmaxf(v1[e], 0.f); v0[e] = a * a; v1[e] = b * b; } }
                    u32x4 w; w.x = cvt_pk_bf16(v0[0], v0[1]); w.y = cvt_pk_bf16(v0[2], v0[3]); w.z = cvt_pk_bf16(v1[0], v1[1]); w.w = cvt_pk_bf16(v1[2], v1[3]);
                    *(u32x4*)(rowp + bj * 128) = w; } }
    }
};
template <int MT> struct EpiInProj {
    static constexpr bool PERM = true, AFTER_DRAIN = false;
    float* PROJ; bf16_t* UV;
    __device__ __forceinline__ void operator()(const f32x4 (&acc)[2][2][MT][2], const pg8::Unit& u, int wr, int wc, int fr, int fq) const {
        const int row0 = u.pm * (64 * MT) + wr * (16 * MT) + fr, colt = wc * 32 + 8 * fq;
        if (u.pn < 2) {
#pragma unroll
            for (int ai = 0; ai < 2; ++ai)
#pragma unroll
                for (int m = 0; m < MT; ++m) { float* rowp = PROJ + (size_t)(row0 + ai * (32 * MT) + m * 16) * 512 + u.pn * 256 + colt;
#pragma unroll
                    for (int bj = 0; bj < 2; ++bj) { *(f32x4*)(rowp + bj * 128) = acc[ai][bj][m][0]; *(f32x4*)(rowp + bj * 128 + 4) = acc[ai][bj][m][1]; } }
        } else {
#pragma unroll
            for (int ai = 0; ai < 2; ++ai)
#pragma unroll
                for (int m = 0; m < MT; ++m) { bf16_t* rowp = UV + (size_t)(row0 + ai * (32 * MT) + m * 16) * 1024 + (u.pn - 2) * 256 + colt;
#pragma unroll
                    for (int bj = 0; bj < 2; ++bj) { f32x4 v0 = acc[ai][bj][m][0], v1 = acc[ai][bj][m][1];
#pragma unroll
                        for (int e = 0; e < 4; ++e) { v0[e] = gelu_tanh(v0[e]); v1[e] = gelu_tanh(v1[e]); }
                        u32x4 w; w.x = cvt_pk_bf16(v0[0], v0[1]); w.y = cvt_pk_bf16(v0[2], v0[3]); w.z = cvt_pk_bf16(v1[0], v1[1]); w.w = cvt_pk_bf16(v1[2], v1[3]);
                        *(u32x4*)(rowp + bj * 128) = w; } }
        }
    }
};
template <int MT> struct EpiQ {
    static constexpr bool PERM = true, AFTER_DRAIN = false;
    bf16_t* Q; const float* rope;
    __device__ __forceinline__ void operator()(const f32x4 (&acc)[2][2][MT][2], const pg8::Unit& u, int wr, int wc, int fr, int fq) const {
        const int row0 = u.pm * (64 * MT) + wr * (16 * MT) + fr, col0 = u.pn * 256 + wc * 32 + 8 * fq;
#pragma unroll
        for (int ai = 0; ai < 2; ++ai)
#pragma unroll
            for (int m = 0; m < MT; ++m) { const int row = row0 + ai * (32 * MT) + m * 16; bf16_t* rowp = Q + (size_t)row * 768 + col0; const bool lat = row >= NCTX;
#pragma unroll
                for (int bj = 0; bj < 2; ++bj) { f32x4 v0 = acc[ai][bj][m][0], v1 = acc[ai][bj][m][1];
                    const int hc = (col0 + bj * 128) % 96;
                    if (lat && hc >= 64) { const int t = (row - NCTX) & 1023; const f32x4* rp = (const f32x4*)(rope + (size_t)t * 32 + (hc - 64));
                        const f32x4 r0 = rp[0], r1 = rp[1];
                        f32x4 o0, o1;
                        o0[0] = v0[0] * r0[0] - v0[1] * r0[1]; o0[1] = v0[0] * r0[1] + v0[1] * r0[0];
                        o0[2] = v0[2] * r0[2] - v0[3] * r0[3]; o0[3] = v0[2] * r0[3] + v0[3] * r0[2];
                        o1[0] = v1[0] * r1[0] - v1[1] * r1[1]; o1[1] = v1[0] * r1[1] + v1[1] * r1[0];
                        o1[2] = v1[2] * r1[2] - v1[3] * r1[3]; o1[3] = v1[2] * r1[3] + v1[3] * r1[2];
                        v0 = o0; v1 = o1; }
                    v0 = v0 * QSCALE; v1 = v1 * QSCALE;
                    u32x4 w; w.x = cvt_pk_bf16(v0[0], v0[1]); w.y = cvt_pk_bf16(v0[2], v0[3]); w.z = cvt_pk_bf16(v1[0], v1[1]); w.w = cvt_pk_bf16(v1[2], v1[3]);
                    *(u32x4*)(rowp + bj * 128) = w; } }
    }
};

__device__ __forceinline__ unsigned pk2(float lo, float hi) { return cvt_pk_bf16(lo, hi); }
__device__ __forceinline__ void transpose_item(const float* W, int K, int N, bf16_t* WT, int k0, int n0, int dst_row0, LAS float* scr, int lane) {
#pragma unroll 8
    for (int i = 0; i < 32; ++i) { const int kk = 2 * i + (lane >> 5); scr[kk * 33 + (lane & 31)] = W[(size_t)(k0 + kk) * N + n0 + (lane & 31)]; }
    asm volatile("s_waitcnt lgkmcnt(0)" ::: "memory");
    const int c = lane & 7;
#pragma unroll
    for (int j = 0; j < 4; ++j) { const int n = (lane >> 3) + 8 * j; const LAS float* s = scr + (8 * c) * 33 + n;
        u32x4 o; o.x = pk2(s[0 * 33], s[1 * 33]); o.y = pk2(s[2 * 33], s[3 * 33]); o.z = pk2(s[4 * 33], s[5 * 33]); o.w = pk2(s[6 * 33], s[7 * 33]);
        *(u32x4*)(WT + (size_t)(dst_row0 + n) * K + k0 + 8 * c) = o; }
    asm volatile("s_waitcnt lgkmcnt(0)" ::: "memory");
}
__device__ __forceinline__ void phase0(const Params& p, LAS unsigned char* lds) {
    int tid0_ = threadIdx.x; asm volatile("" : "+v"(tid0_)); const int tid = tid0_, lane = tid & 63, wave = tid >> 6, G = gridDim.x;
    unsigned char* ws = p.ws;
    float* MOD = (float*)(ws + WS_MOD);
    for (int s = blockIdx.x; s < 192; s += G) {
        LAS float* sl = (LAS float*)lds; LAS float* red = sl + 5 * 1024;
        for (int e = tid; e < 5 * 1024; e += 512) { const int i = e >> 10, k = e & 1023; const float v = (i == 0) ? p.c_ctx[k] : p.c[(i - 1) * 1024 + k]; sl[e] = v / (1.0f + expf(-v)); }
        __syncthreads();
        const int col = tid & 31, kg = tid >> 5;
        float a0 = 0.f, a1 = 0.f, a2 = 0.f, a3 = 0.f, a4 = 0.f;
        const float* w = p.w_mod + (size_t)(kg * 64) * 6144 + s * 32 + col;
#pragma unroll 8
        for (int kk = 0; kk < 64; ++kk) { const float wv = w[(size_t)kk * 6144]; const int k = kg * 64 + kk;
            a0 += sl[k] * wv; a1 += sl[1024 + k] * wv; a2 += sl[2048 + k] * wv; a3 += sl[3072 + k] * wv; a4 += sl[4096 + k] * wv; }
        red[(kg * 5 + 0) * 32 + col] = a0; red[(kg * 5 + 1) * 32 + col] = a1; red[(kg * 5 + 2) * 32 + col] = a2; red[(kg * 5 + 3) * 32 + col] = a3; red[(kg * 5 + 4) * 32 + col] = a4;
        __syncthreads();
        if (tid < 160) { const int i = tid >> 5, cc = tid & 31; float sum = p.b_mod[s * 32 + cc];
#pragma unroll
            for (int g = 0; g < 16; ++g) sum += red[(g * 5 + i) * 32 + cc];
            MOD[i * 6144 + s * 32 + cc] = sum; }
        __syncthreads();
    }
    {
        LAS float* scr = (LAS float*)(lds + wave * 16384);
        const int gw = blockIdx.x * 8 + wave, NGW = G * 8;
        constexpr int I_IN = 16 * 45, I_UQ = 4 * 24, I_UKV = 2 * 32, I_O = 16 * 32, I_1 = 16 * 128, I_2 = 64 * 32;
        constexpr int NIT = I_IN + I_UQ + I_UKV + I_O + I_1 + I_2;
        for (int it = gw; it < NIT; it += NGW) {
            int r = it;
            if (r < I_IN) { const int kb = r / 45, nb = r % 45, n0 = nb * 32; transpose_item(p.w_in, 1024, 1440, (bf16_t*)(ws + WS_WIN), kb * 64, n0, n0 < 416 ? n0 : n0 + 96, scr, lane); continue; } r -= I_IN;
            if (r < I_UQ) { const int kb = r / 24, nb = r % 24; transpose_item(p.w_uq, 256, 768, (bf16_t*)(ws + WS_WUQ), kb * 64, nb * 32, nb * 32, scr, lane); continue; } r -= I_UQ;
            if (r < I_UKV) { const int kb = r / 32, nb = r % 32, n0 = nb * 32, h = n0 >> 7, wi = n0 & 127;
                if (wi < 64) transpose_item(p.w_ukv, 128, 1024, (bf16_t*)(ws + WS_WK), kb * 64, n0, h * 64 + wi, scr, lane);
                else transpose_item(p.w_ukv, 128, 1024, (bf16_t*)(ws + WS_WV), kb * 64, n0, h * 64 + wi - 64, scr, lane);
                continue; } r -= I_UKV;
            if (r < I_O) { const int kb = r / 32, nb = r % 32; transpose_item(p.w_o, 1024, 1024, (bf16_t*)(ws + WS_WO), kb * 64, nb * 32, nb * 32, scr, lane); continue; } r -= I_O;
            if (r < I_1) { const int kb = r / 128, nb = r % 128; transpose_item(p.w_ff1, 1024, 4096, (bf16_t*)(ws + WS_W1), kb * 64, nb * 32, nb * 32, scr, lane); continue; } r -= I_1;
            { const int kb = r / 32, nb = r % 32; transpose_item(p.w_ff2, 4096, 1024, (bf16_t*)(ws + WS_W2), kb * 64, nb * 32, nb * 32, scr, lane); }
        }
    }
    {
        const int gt = blockIdx.x * 512 + tid, NGT = G * 512;
        bf16_t* wsgu = (bf16_t*)(ws + WS_WSGU);
        for (int e = gt; e < 8 * 128 * 128 / 2; e += NGT) ((unsigned*)wsgu)[e] = pk2(p.w_sgu[2 * e], p.w_sgu[2 * e + 1]);
        unsigned* pad = (unsigned*)((bf16_t*)(ws + WS_WIN) + (size_t)416 * 1024);
        for (int e = gt; e < 96 * 1024 / 2; e += NGT) pad[e] = 0u;
        float* rope = (float*)(ws + WS_ROPE);
        for (int e = gt; e < 1024 * 16; e += NGT) { const int t = e >> 4, i = e & 15, j = i & 7; const float pos = (float)((i < 8) ? (t >> 6) : (t & 63));
            const float freq = 1.0f / powf(10000.0f, (float)j * 0.125f); const float ang = pos * freq; float sn, cs; sincosf(ang, &sn, &cs); rope[2 * e] = cs; rope[2 * e + 1] = sn; }
    }
}

__device__ __forceinline__ void phase_xn(const Params& p) {
    int tid0_ = threadIdx.x; asm volatile("" : "+v"(tid0_)); const int tid = tid0_, lane = tid & 63, wave = tid >> 6;
    const int gw = blockIdx.x * 8 + wave, NGW = gridDim.x * 8;
    const float* MOD = (const float*)(p.ws + WS_MOD); bf16_t* H = (bf16_t*)(p.ws + WS_H);
    for (int r = gw; r < MTOK; r += NGW) {
        const f32x4* xr = (const f32x4*)xrow(p, r) + lane; const float* md = MOD + cls_of(r) * 6144;
        f32x4 v[4]; float s = 0.f;
#pragma unroll
        for (int j = 0; j < 4; ++j) { v[j] = xr[64 * j]; s += (v[j][0] * v[j][0] + v[j][1] * v[j][1]) + (v[j][2] * v[j][2] + v[j][3] * v[j][3]); }
        const float rstd = 1.0f / sqrtf(wave_sum(s) * (1.0f / D) + EPS);
#pragma unroll
        for (int j = 0; j < 4; ++j) { const int col = 4 * lane + 256 * j;
            const f32x4 g = *(const f32x4*)(p.g_attn_pre + col), sh = *(const f32x4*)(md + col), sc = *(const f32x4*)(md + 1024 + col);
            const f32x4 o = v[j] * rstd * g * (sc + 1.0f) + sh;
            u32x2 w; w.x = pk2(o[0], o[1]); w.y = pk2(o[2], o[3]); *(u32x2*)(H + (size_t)r * D + col) = w; }
    }
}

__device__ __forceinline__ void phase_prep(const Params& p) {
    int tid0_ = threadIdx.x; asm volatile("" : "+v"(tid0_)); const int tid = tid0_, lane = tid & 63, wave = tid >> 6;
    const int gw = blockIdx.x * 8 + wave, NGW = gridDim.x * 8;
    unsigned char* ws = p.ws;
    const float* PROJ = (const float*)(ws + WS_PROJ); const bf16_t* UV = (const bf16_t*)(ws + WS_UV);
    bf16_t* CQN = (bf16_t*)(ws + WS_CQN); bf16_t* CKVN = (bf16_t*)(ws + WS_CKVN); bf16_t* KR = (bf16_t*)(ws + WS_KR);
    float* VSTAT = (float*)(ws + WS_VSTAT); const float* rope = (const float*)(ws + WS_ROPE);
    for (int r = gw; r < MTOK + 1024; r += NGW) {
        if (r >= MTOK) {
            const int j = r - MTOK, b = j >> 8, pp = j & 255; const size_t kvr = (size_t)NCTX + b * 1280 + pp;
            const f32x2 cv = *(const f32x2*)(p.cache_ckv + (size_t)j * 128 + 2 * lane);
            *(unsigned*)(CKVN + kvr * 128 + 2 * lane) = pk2(cv[0], cv[1]);
            if (lane < 16) { const f32x2 kv = *(const f32x2*)(p.cache_krope + (size_t)j * 32 + 2 * lane); *(unsigned*)(KR + kvr * 32 + 2 * lane) = pk2(kv[0], kv[1]); }
            continue;
        }
        const float* pr = PROJ + (size_t)r * 512; const size_t kvr = (size_t)kvrow_of(r);
        { const f32x4 v = *(const f32x4*)(pr + 4 * lane); const float s = wave_sum((v[0] * v[0] + v[1] * v[1]) + (v[2] * v[2] + v[3] * v[3]));
          const float rstd = 1.0f / sqrtf(s * (1.0f / 256.0f) + EPS); const f32x4 g = *(const f32x4*)(p.g_q + 4 * lane); const f32x4 o = v * rstd * g;
          u32x2 w; w.x = pk2(o[0], o[1]); w.y = pk2(o[2], o[3]); *(u32x2*)(CQN + (size_t)r * 256 + 4 * lane) = w; }
        { const f32x2 v = *(const f32x2*)(pr + 256 + 2 * lane); const float s = wave_sum(v[0] * v[0] + v[1] * v[1]);
          const float rstd = 1.0f / sqrtf(s * (1.0f / 128.0f) + EPS); const f32x2 g = *(const f32x2*)(p.g_kv + 2 * lane); const f32x2 o = v * rstd * g;
          if (r < NCTX) *(f32x2*)(p.out + OUT_CKV + (size_t)r * 128 + 2 * lane) = o;
          *(unsigned*)(CKVN + kvr * 128 + 2 * lane) = pk2(o[0], o[1]); }
        if (lane < 16) { f32x2 v = *(const f32x2*)(pr + 384 + 2 * lane);
          if (r < NCTX) *(f32x2*)(p.out + OUT_KR + (size_t)r * 32 + 2 * lane) = v;
          else { const int t = (r - NCTX) & 1023; const f32x2 cs = *(const f32x2*)(rope + (size_t)t * 32 + 2 * lane); v = (f32x2){v[0] * cs[0] - v[1] * cs[1], v[0] * cs[1] + v[1] * cs[0]}; }
          *(unsigned*)(KR + kvr * 32 + 2 * lane) = pk2(v[0], v[1]); }
        { const u32x4 w = *(const u32x4*)(UV + (size_t)r * 1024 + 512 + 8 * lane);
          float x[8] = {bflo(w.x), bfhi(w.x), bflo(w.y), bfhi(w.y), bflo(w.z), bfhi(w.z), bflo(w.w), bfhi(w.w)};
          float s = 0.f;
#pragma unroll
          for (int e = 0; e < 8; ++e) s += x[e];
          const float mean = wave_sum(s) * (1.0f / 512.0f); float q = 0.f;
#pragma unroll
          for (int e = 0; e < 8; ++e) { const float d = x[e] - mean; q += d * d; }
          const float rstd = 1.0f / sqrtf(wave_sum(q) * (1.0f / 512.0f) + EPS);
          if (lane == 0) *(f32x2*)(VSTAT + 2 * (size_t)r) = (f32x2){mean, rstd}; }
    }
}

__device__ __forceinline__ void sgu_unit(const Params& p, LAS unsigned char* lds, int chunk, int g) {
    int tid0_ = threadIdx.x; asm volatile("" : "+v"(tid0_)); const int tid = tid0_, lane = tid & 63, wave = tid >> 6, fr = lane & 15, g4 = lane >> 4;
    unsigned char* ws = p.ws;
    const bf16_t* UV = (const bf16_t*)(ws + WS_UV); const float* VSTAT = (const float*)(ws + WS_VSTAT); const bf16_t* WS = (const bf16_t*)(ws + WS_WSGU);
    bf16_t* MIX = (bf16_t*)(ws + WS_MIX);
    const int r0 = chunk * 128;
    LAS bf16_t* vnT = (LAS bf16_t*)lds;
    { const int row = tid >> 2, cc = (tid & 3) * 16;
      const bf16_t* src = UV + (size_t)(r0 + row) * 1024 + 512 + g * 64 + cc;
      const u32x4 w0 = *(const u32x4*)src, w1 = *(const u32x4*)(src + 8);
      const f32x2 st = *(const f32x2*)(VSTAT + 2 * (size_t)(r0 + row));
      const float x[16] = {bflo(w0.x), bfhi(w0.x), bflo(w0.y), bfhi(w0.y), bflo(w0.z), bfhi(w0.z), bflo(w0.w), bfhi(w0.w), bflo(w1.x), bfhi(w1.x), bflo(w1.y), bfhi(w1.y), bflo(w1.z), bfhi(w1.z), bflo(w1.w), bfhi(w1.w)};
#pragma unroll
      for (int e = 0; e < 16; e += 2) { const int c = cc + e;
          const f32x2 gg = *(const f32x2*)(p.g_sgu + g * 64 + c), bb = *(const f32x2*)(p.beta_sgu + g * 64 + c);
          const unsigned w = pk2((x[e] - st[0]) * st[1] * gg[0] + bb[0], (x[e + 1] - st[0]) * st[1] * gg[1] + bb[1]);
          vnT[c * 136 + row] = (bf16_t)(w & 0xffffu); vnT[(c + 1) * 136 + row] = (bf16_t)(w >> 16); } }
    __syncthreads();
    bf16x8 bfr[4];
    { const bf16_t* wp = WS + (size_t)g * 16384 + (size_t)(16 * wave + fr) * 128 + 8 * g4;
#pragma unroll
      for (int ks = 0; ks < 4; ++ks) bfr[ks] = *(const bf16x8*)(wp + 32 * ks); }
    const int token = r0 + 16 * wave + fr; const float bias = p.b_sgu[g * 128 + 16 * wave + fr];
#pragma unroll
    for (int j = 0; j < 4; ++j) { f32x4 acc = {0.f, 0.f, 0.f, 0.f};
#pragma unroll
        for (int ks = 0; ks < 4; ++ks) { const bf16x8 a = *(const LAS bf16x8*)(vnT + (16 * j + fr) * 136 + 32 * ks + 8 * g4); acc = __builtin_amdgcn_mfma_f32_16x16x32_bf16(a, bfr[ks], acc, 0, 0, 0); }
        const int c = 16 * j + 4 * g4; const u32x2 uw = *(const u32x2*)(UV + (size_t)token * 1024 + g * 64 + c);
        u32x2 o; o.x = pk2((acc[0] + bias) * bflo(uw.x), (acc[1] + bias) * bfhi(uw.x)); o.y = pk2((acc[2] + bias) * bflo(uw.y), (acc[3] + bias) * bfhi(uw.y));
        *(u32x2*)(MIX + (size_t)token * 1024 + 512 + g * 64 + c) = o; }
    __syncthreads();
}

__device__ __forceinline__ void attn_unit(const Params& p, LAS unsigned char* lds, int q0, int kv0, int NK, int h) {
    int tid0_ = threadIdx.x; asm volatile("" : "+v"(tid0_)); const int tid = tid0_, lane = tid & 63, wave = tid >> 6, fr = lane & 15, g4 = lane >> 4;
    unsigned char* ws = p.ws;
    const bf16_t* Q = (const bf16_t*)(ws + WS_Q); const bf16_t* KN = (const bf16_t*)(ws + WS_KN); const bf16_t* KR = (const bf16_t*)(ws + WS_KR); const bf16_t* VT = (const bf16_t*)(ws + WS_VT);
    bf16_t* MIX = (bf16_t*)(ws + WS_MIX);
    constexpr int KS = 208, VS = 144, VOFF = 64 * KS, BUFB = 64 * KS + 64 * VS;
    bf16x8 qf[3];
    { const bf16_t* qp = Q + (size_t)(q0 + wave * 16 + fr) * 768 + h * 96 + g4 * 8;
#pragma unroll
      for (int kd = 0; kd < 3; ++kd) qf[kd] = *(const bf16x8*)(qp + kd * 32); }
    f32x4 o[4];
#pragma unroll
    for (int dj = 0; dj < 4; ++dj) o[dj] = (f32x4){0.f, 0.f, 0.f, 0.f};
    float m = -1e30f, l = 0.f;
    const int NT = NK / 64;
    const int krow = tid >> 3, kch = tid & 7, rrow = tid >> 2, rch = tid & 3;
    const bf16_t* kn_src = KN + (size_t)(kv0 + krow) * 512 + h * 64 + kch * 8;
    const bf16_t* kr_src = KR + (size_t)(kv0 + (rrow & 63)) * 32 + rch * 8;
    const bf16_t* vt_src = VT + (size_t)(h * 64 + krow) * NKV + kv0 + kch * 8;
    u32x4 rk, rr, rv;
    rk = *(const u32x4*)kn_src; rv = *(const u32x4*)vt_src; if (tid < 256) rr = *(const u32x4*)kr_src;
    *(LAS u32x4*)(lds + krow * KS + kch * 16) = rk; *(LAS u32x4*)(lds + VOFF + krow * VS + kch * 16) = rv; if (tid < 256) *(LAS u32x4*)(lds + rrow * KS + 128 + rch * 16) = rr;
    __syncthreads();
    for (int t = 0; t < NT; ++t) {
        LAS unsigned char* buf = lds + (t & 1) * BUFB;
        if (t + 1 < NT) { rk = *(const u32x4*)(kn_src + (size_t)(t + 1) * 64 * 512); rv = *(const u32x4*)(vt_src + (t + 1) * 64); if (tid < 256) rr = *(const u32x4*)(kr_src + (size_t)(t + 1) * 64 * 32); }
        f32x4 s[4];
#pragma unroll
        for (int a = 0; a < 4; ++a) { s[a] = (f32x4){0.f, 0.f, 0.f, 0.f};
#pragma unroll
            for (int kd = 0; kd < 3; ++kd) { const bf16x8 kf = *(const LAS bf16x8*)(buf + (16 * a + fr) * KS + kd * 64 + g4 * 16); s[a] = __builtin_amdgcn_mfma_f32_16x16x32_bf16(kf, qf[kd], s[a], 0, 0, 0); } }
        float mx = fmaxf(fmaxf(s[0][0], s[0][1]), fmaxf(s[0][2], s[0][3]));
#pragma unroll
        for (int a = 1; a < 4; ++a) mx = fmaxf(mx, fmaxf(fmaxf(s[a][0], s[a][1]), fmaxf(s[a][2], s[a][3])));
        mx = fmaxf(mx, __shfl_xor(mx, 16)); mx = fmaxf(mx, __shfl_xor(mx, 32));
        const float mn = fmaxf(m, mx); const float alpha = __builtin_amdgcn_exp2f(m - mn); m = mn;
        l *= alpha;
#pragma unroll
        for (int dj = 0; dj < 4; ++dj) o[dj] = o[dj] * alpha;
        float ps = 0.f;
#pragma unroll
        for (int a = 0; a < 4; ++a)
#pragma unroll
            for (int e = 0; e < 4; ++e) { s[a][e] = __builtin_amdgcn_exp2f(s[a][e] - mn); ps += s[a][e]; }
        l += ps;
#pragma unroll
        for (int ks = 0; ks < 2; ++ks) {
            u32x4 pw; pw.x = pk2(s[2 * ks][0], s[2 * ks][1]); pw.y = pk2(s[2 * ks][2], s[2 * ks][3]); pw.z = pk2(s[2 * ks + 1][0], s[2 * ks + 1][1]); pw.w = pk2(s[2 * ks + 1][2], s[2 * ks + 1][3]);
            const bf16x8 pf = __builtin_bit_cast(bf16x8, pw);
#pragma unroll
            for (int dj = 0; dj < 4; ++dj) { const LAS unsigned char* vp = buf + VOFF + (16 * dj + fr) * VS + (32 * ks + 4 * g4) * 2;
                const u32x2 lo = *(const LAS u32x2*)vp, hi = *(const LAS u32x2*)(vp + 32);
                u32x4 vw; vw.x = lo.x; vw.y = lo.y; vw.z = hi.x; vw.w = hi.y;
                o[dj] = __builtin_amdgcn_mfma_f32_16x16x32_bf16(__builtin_bit_cast(bf16x8, vw), pf, o[dj], 0, 0, 0); }
        }
        if (t + 1 < NT) { LAS unsigned char* nb = lds + ((t + 1) & 1) * BUFB;
            *(LAS u32x4*)(nb + krow * KS + kch * 16) = rk; *(LAS u32x4*)(nb + VOFF + krow * VS + kch * 16) = rv; if (tid < 256) *(LAS u32x4*)(nb + rrow * KS + 128 + rch * 16) = rr; }
        __syncthreads();
    }
    l += __shfl_xor(l, 16); l += __shfl_xor(l, 32);
    const float inv = 1.0f / l;
    bf16_t* op = MIX + (size_t)(q0 + wave * 16 + fr) * 1024 + h * 64 + 4 * g4;
#pragma unroll
    for (int dj = 0; dj < 4; ++dj) { u32x2 w; w.x = pk2(o[dj][0] * inv, o[dj][1] * inv); w.y = pk2(o[dj][2] * inv, o[dj][3] * inv); *(u32x2*)(op + 16 * dj) = w; }
}
__device__ __forceinline__ void phase_attn(const Params& p, LAS unsigned char* lds) {
    for (int u = blockIdx.x; u < 768; u += gridDim.x) {
        if (u < 256) { const int b = u >> 6, h = (u >> 3) & 7, qb = u & 7; attn_unit(p, lds, NCTX + b * 1024 + qb * 128, NCTX + b * 1280, 1280, h); }
        else { const int v = u - 256, b = v >> 4, h = (v >> 1) & 7, qb = v & 1; attn_unit(p, lds, b * 256 + qb * 128, b * 256, 256, h); }
    }
}

__device__ __forceinline__ void phase_post1(const Params& p) {
    int tid0_ = threadIdx.x; asm volatile("" : "+v"(tid0_)); const int tid = tid0_, lane = tid & 63, wave = tid >> 6;
    const int gw = blockIdx.x * 8 + wave, NGW = gridDim.x * 8;
    const float* MOD = (const float*)(p.ws + WS_MOD); const bf16_t* MIXO = (const bf16_t*)(p.ws + WS_MIXO); bf16_t* H = (bf16_t*)(p.ws + WS_H);
    for (int r = gw; r < MTOK; r += NGW) {
        const float* xr = xrow(p, r); const float* md = MOD + cls_of(r) * 6144; float* yr = p.out + OUT_Y + (size_t)r * D;
        float mv[16]; float s = 0.f;
#pragma unroll
        for (int j = 0; j < 2; ++j) { const u32x4 w = *(const u32x4*)(MIXO + (size_t)r * D + 8 * lane + 512 * j);
            mv[8 * j + 0] = bflo(w.x); mv[8 * j + 1] = bfhi(w.x); mv[8 * j + 2] = bflo(w.y); mv[8 * j + 3] = bfhi(w.y); mv[8 * j + 4] = bflo(w.z); mv[8 * j + 5] = bfhi(w.z); mv[8 * j + 6] = bflo(w.w); mv[8 * j + 7] = bfhi(w.w); }
#pragma unroll
        for (int e = 0; e < 16; ++e) s += mv[e] * mv[e];
        const float rs = 1.0f / sqrtf(wave_sum(s) * (1.0f / D) + EPS);
        float x1[16]; float s1 = 0.f;
#pragma unroll
        for (int j = 0; j < 2; ++j)
#pragma unroll
            for (int q = 0; q < 2; ++q) { const int col = 8 * lane + 512 * j + 4 * q;
                const f32x4 xv = *(const f32x4*)(xr + col), ga = *(const f32x4*)(md + 2048 + col), gp = *(const f32x4*)(p.g_attn_post + col);
#pragma unroll
                for (int e = 0; e < 4; ++e) { const float v = xv[e] + ga[e] * (mv[8 * j + 4 * q + e] * rs * gp[e]); x1[8 * j + 4 * q + e] = v; s1 += v * v; }
                *(f32x4*)(yr + col) = (f32x4){x1[8 * j + 4 * q], x1[8 * j + 4 * q + 1], x1[8 * j + 4 * q + 2], x1[8 * j + 4 * q + 3]}; }
        const float r1 = 1.0f / sqrtf(wave_sum(s1) * (1.0f / D) + EPS);
#pragma unroll
        for (int j = 0; j < 2; ++j) { const int col = 8 * lane + 512 * j; float hv[8];
#pragma unroll
            for (int q = 0; q < 2; ++q) { const f32x4 g = *(const f32x4*)(p.g_ffn_pre + col + 4 * q), sh = *(const f32x4*)(md + 3072 + col + 4 * q), sc = *(const f32x4*)(md + 4096 + col + 4 * q);
#pragma unroll
                for (int e = 0; e < 4; ++e) hv[4 * q + e] = x1[8 * j + 4 * q + e] * r1 * g[e] * (1.0f + sc[e]) + sh[e]; }
            u32x4 w; w.x = pk2(hv[0], hv[1]); w.y = pk2(hv[2], hv[3]); w.z = pk2(hv[4], hv[5]); w.w = pk2(hv[6], hv[7]);
            *(u32x4*)(H + (size_t)r * D + col) = w; }
    }
}
__device__ __forceinline__ void phase_final(const Params& p) {
    int tid0_ = threadIdx.x; asm volatile("" : "+v"(tid0_)); const int tid = tid0_, lane = tid & 63, wave = tid >> 6;
    const int gw = blockIdx.x * 8 + wave, NGW = gridDim.x * 8;
    const float* MOD = (const float*)(p.ws + WS_MOD); const bf16_t* F = (const bf16_t*)(p.ws + WS_F);
    for (int r = gw; r < MTOK; r += NGW) {
        const float* md = MOD + cls_of(r) * 6144; float* yr = p.out + OUT_Y + (size_t)r * D;
        float fv[16]; float s = 0.f;
#pragma unroll
        for (int j = 0; j < 2; ++j) { const u32x4 w = *(const u32x4*)(F + (size_t)r * D + 8 * lane + 512 * j);
            fv[8 * j + 0] = bflo(w.x); fv[8 * j + 1] = bfhi(w.x); fv[8 * j + 2] = bflo(w.y); fv[8 * j + 3] = bfhi(w.y); fv[8 * j + 4] = bflo(w.z); fv[8 * j + 5] = bfhi(w.z); fv[8 * j + 6] = bflo(w.w); fv[8 * j + 7] = bfhi(w.w); }
#pragma unroll
        for (int e = 0; e < 16; ++e) s += fv[e] * fv[e];
        const float rs = 1.0f / sqrtf(wave_sum(s) * (1.0f / D) + EPS);
#pragma unroll
        for (int j = 0; j < 2; ++j)
#pragma unroll
            for (int q = 0; q < 2; ++q) { const int col = 8 * lane + 512 * j + 4 * q;
                const f32x4 xv = *(const f32x4*)(yr + col), gf = *(const f32x4*)(md + 5120 + col), gp = *(const f32x4*)(p.g_ffn_post + col);
                f32x4 y;
#pragma unroll
                for (int e = 0; e < 4; ++e) y[e] = xv[e] + gf[e] * (fv[8 * j + 4 * q + e] * rs * gp[e]);
                *(f32x4*)(yr + col) = y; }
    }
}

#define XB_TMO      128
#define XB_XCNT(j)  (256  + 64 * (j))
#define XB_XSUB(j)  (1280 + 64 * (j))
#define XB_XGEN(j)  (2304 + 64 * (j))
#define XB_TOP      3328
#define XB_TOPGEN   3392
#define XCD_BAR_WORDS 3456
#define XB_SPIN_CAP (1u << 18)

__device__ __forceinline__ unsigned xb_ld(unsigned* p)              { return __hip_atomic_load(p, __ATOMIC_RELAXED, __HIP_MEMORY_SCOPE_AGENT); }
__device__ __forceinline__ unsigned xb_add(unsigned* p, unsigned v) { return __hip_atomic_fetch_add(p, v, __ATOMIC_RELAXED, __HIP_MEMORY_SCOPE_AGENT); }
__device__ __forceinline__ unsigned xb_xcc_id() { return (unsigned)__builtin_amdgcn_s_getreg((3 << 11) | 20) & 0xFu; }
#define XB_SPIN(cond, bar) do { unsigned _sp = 0; while (cond) { __builtin_amdgcn_s_sleep(1); \
    if ((++_sp & 255u) == 0u) { if (xb_ld(&(bar)[XB_TMO])) break; if (_sp > XB_SPIN_CAP) { atomicAdd(&(bar)[XB_TMO], 1u); break; } } } } while (0)

struct XcdBarrier {
    unsigned* bar; unsigned x;
    volatile LAS unsigned* st;
};

__device__ __forceinline__ XcdBarrier xcd_barrier_post(unsigned* bar, volatile LAS unsigned* st) {
    XcdBarrier b; b.bar = bar; b.x = xb_xcc_id(); b.st = st;
    if (threadIdx.x == 0) (void)xb_add(&bar[XB_XCNT(b.x)], 1u);
    return b;
}
__device__ __forceinline__ void xcd_barrier_complete(unsigned* bar, unsigned x, unsigned& nloc, unsigned& nx) {
    const unsigned G = gridDim.x * gridDim.y * gridDim.z;
    unsigned sum, cnt, mine, sp = 0u;
    for (;;) {
        sum = 0u; cnt = 0u; mine = 0u;
#pragma unroll
        for (unsigned j = 0; j < 16; ++j) { const unsigned c = xb_ld(&bar[XB_XCNT(j)]); sum += c; cnt += (c > 0u) ? 1u : 0u; mine = (j == x) ? c : mine; }
        if (sum == G) break;
        __builtin_amdgcn_s_sleep(1);
        if ((++sp & 255u) == 0u) { if (xb_ld(&bar[XB_TMO])) break; if (sp > XB_SPIN_CAP) { atomicAdd(&bar[XB_TMO], 1u); break; } }
    }
    nloc = mine > 0u ? mine : 1u; nx = cnt > 0u ? cnt : 1u;
}

__device__ __forceinline__ void xcd_barrier(const XcdBarrier& b) {
    asm volatile("s_waitcnt vmcnt(0)" ::: "memory");
    __syncthreads();
    if (threadIdx.x == 0) {
        unsigned* bar = b.bar;
        __builtin_amdgcn_s_waitcnt(0);
        unsigned nloc = b.st[0], nx = b.st[1];
        if (nloc == 0u) { xcd_barrier_complete(bar, b.x, nloc, nx); b.st[0] = nloc; b.st[1] = nx; }
        const unsigned old = xb_add(&bar[XB_XSUB(b.x)], 1u);
        const unsigned gen = old / nloc;
        if (old + 1u == (gen + 1u) * nloc) {
            __builtin_amdgcn_fence(__ATOMIC_RELEASE, "agent");
            asm volatile("s_waitcnt vmcnt(0)" ::: "memory");
            const unsigned og = xb_add(&bar[XB_TOP], 1u);
            const unsigned tg = og / nx;
            if (og + 1u == (tg + 1u) * nx) xb_add(&bar[XB_TOPGEN], 1u);
            else XB_SPIN(xb_ld(&bar[XB_TOPGEN]) == tg, bar);
            __builtin_amdgcn_fence(__ATOMIC_ACQUIRE, "agent");
            xb_add(&bar[XB_XGEN(b.x)], 1u);
            asm volatile("s_waitcnt vmcnt(0)" ::: "memory");
        } else {
            XB_SPIN(xb_ld(&bar[XB_XGEN(b.x)]) == gen, bar);
            __builtin_amdgcn_fence(__ATOMIC_ACQUIRE, "agent");
            asm volatile("s_waitcnt vmcnt(0)" ::: "memory");
        }
    }
    __syncthreads();
}
constexpr int LDS_BYTES = 131072 + 1024;
#define GSYNC() xcd_barrier(bar)
template <int MT, class Epi> __device__ __forceinline__ void run_gemm(LAS unsigned char* lds, const bf16_t* A, const bf16_t* Bt, int M, int N, int K, const Epi& E) {
    pg8::Gemm g{A, Bt, M, N, K}; pg8::StaticOrder S; S.init(M, N, (int)gridDim.x, (int)blockIdx.x, 64 * MT);
    pg8::gemm_phase<Epi, pg8::StaticOrder, true, true, MT>(lds, g, S, E);
}
__global__ void __launch_bounds__(512, 2) fwd_megakernel(Params p) {
    extern __shared__ __attribute__((aligned(16))) unsigned char smem[];
    LAS unsigned char* lds = (LAS unsigned char*)smem;
    unsigned char* ws = p.ws;
    if (ws == nullptr) { cg::this_grid().sync(); }
    { volatile LAS unsigned* st = (volatile LAS unsigned*)(lds + 131072); if (threadIdx.x < 64) st[threadIdx.x] = 0u; }
    __syncthreads();
    XcdBarrier bar = xcd_barrier_post((unsigned*)(ws + WS_BAR), (volatile LAS unsigned*)(lds + 131072 + 32));
#ifndef PH
#define PH 0xFFFF
#endif
#if PH & 1
    phase0(p, lds);
#endif
    GSYNC();
#if PH & 2
    phase_xn(p);
#endif
    GSYNC();
#if PH & 4
    { EpiInProj<3> E{(float*)(ws + WS_PROJ), (bf16_t*)(ws + WS_UV)}; run_gemm<3>(lds, (const bf16_t*)(ws + WS_H), (const bf16_t*)(ws + WS_WIN), MTOK, NPROJ, 1024, E); }
#endif
    GSYNC();
#if PH & 8
    phase_prep(p);
#endif
    GSYNC();
#if PH & 16
    { EpiQ<3> E{(bf16_t*)(ws + WS_Q), (const float*)(ws + WS_ROPE)}; run_gemm<3>(lds, (const bf16_t*)(ws + WS_CQN), (const bf16_t*)(ws + WS_WUQ), MTOK, 768, 256, E); }
#endif
#if PH & 32
    { EpiStore<0> E{(bf16_t*)(ws + WS_KN), 512}; run_gemm<4>(lds, (const bf16_t*)(ws + WS_CKVN), (const bf16_t*)(ws + WS_WK), NKV, 512, 128, E); }
    { EpiStore<0> E{(bf16_t*)(ws + WS_VT), NKV}; run_gemm<4>(lds, (const bf16_t*)(ws + WS_WV), (const bf16_t*)(ws + WS_CKVN), 512, NKV, 128, E); }
#endif
    __syncthreads();
#if PH & 64
    for (int u = blockIdx.x; u < 768; u += gridDim.x) sgu_unit(p, lds, u >> 3, u & 7);
#endif
    GSYNC();
#if PH & 128
    phase_attn(p, lds);
#endif
    GSYNC();
#if PH & 256
    { EpiStore<0, 3> E{(bf16_t*)(ws + WS_MIXO), 1024}; run_gemm<3>(lds, (const bf16_t*)(ws + WS_MIX), (const bf16_t*)(ws + WS_WO), MTOK, 1024, 1024, E); }
#endif
    GSYNC();
#if PH & 512
    phase_post1(p);
#endif
    GSYNC();
#if PH & 1024
    { EpiStore<1> E{(bf16_t*)(ws + WS_A1), DFF}; run_gemm<4>(lds, (const bf16_t*)(ws + WS_H), (const bf16_t*)(ws + WS_W1), MTOK, DFF, 1024, E); }
#endif
    GSYNC();
#if PH & 2048
    { EpiStore<0, 3> E{(bf16_t*)(ws + WS_F), 1024}; run_gemm<3>(lds, (const bf16_t*)(ws + WS_A1), (const bf16_t*)(ws + WS_W2), MTOK, 1024, DFF, E); }
#endif
    GSYNC();
#if PH & 4096
    phase_final(p);
#endif
}

extern "C" void kernel_launch(void* const* d_in, const int* in_sizes, int n_in, void* d_out, int out_size, void* d_ws, size_t ws_size, hipStream_t stream) {
    static int grid_blocks = 0;
    if (grid_blocks == 0) {
        if (n_in != 24 || ws_size < WS_END) { fprintf(stderr, "kernel_launch: unexpected n_in %d / ws %zu\n", n_in, ws_size); grid_blocks = -1; return; }
        int dev = 0, cus = 0, per_cu = 0;
        hipGetDevice(&dev); hipDeviceGetAttribute(&cus, hipDeviceAttributeMultiprocessorCount, dev);
        hipFuncSetAttribute((const void*)fwd_megakernel, hipFuncAttributeMaxDynamicSharedMemorySize, LDS_BYTES);
        hipOccupancyMaxActiveBlocksPerMultiprocessor(&per_cu, (const void*)fwd_megakernel, 512, LDS_BYTES);
        if (per_cu < 1) { fprintf(stderr, "kernel_launch: occupancy query says %d\n", per_cu); per_cu = 1; }
        grid_blocks = cus;
        (void)hipGetLastError();
    }
    if (grid_blocks < 0) return;
    Params p{};
    const float** pp = (const float**)&p;
    for (int i = 0; i < 24; ++i) pp[i] = (const float*)d_in[i];
    p.out = (float*)d_out; p.ws = (unsigned char*)d_ws;
    if (hipMemsetAsync((unsigned char*)d_ws + WS_BAR, 0, XCD_BAR_WORDS * 4, stream) != hipSuccess) { fprintf(stderr, "memset failed\n"); return; }
    void* args[] = {&p};
    hipError_t e = hipLaunchCooperativeKernel((void*)fwd_megakernel, dim3(grid_blocks), dim3(512), args, LDS_BYTES, stream);
    if (e != hipSuccess) fprintf(stderr, "cooperative launch failed: %s (grid %d)\n", hipGetErrorString(e), grid_blocks);
}
```
